# Optimizing an MI355X kernel written in HIP

```python
import jax, jax.numpy as jnp
from jax import lax
import numpy as np

D_MODEL = 1024
BATCH = 16
SEQ = 2048
DEPTH = 1

D_MIX = D_MODEL
HEAD_DIM = 64
ATT_WIDTH = D_MIX // 2
ATT_Q_HEADS = ATT_WIDTH // HEAD_DIM
ATT_KV_HEADS = 2
ATT_GROUP = ATT_Q_HEADS // ATT_KV_HEADS
ATT_KV_WIDTH = ATT_KV_HEADS * HEAD_DIM
Q_BLOCK = 128
ROPE_THETA = 10000.0
GRID_W = 64
RWKV_WIDTH = D_MIX - ATT_WIDTH
RWKV_HEADS = RWKV_WIDTH // HEAD_DIM
DECAY_RANK = 64
ICLR_RANK = 64
N_DIRS = 2
RWKV_SHIFT_WIDTH = 3 * RWKV_WIDTH + DECAY_RANK + ICLR_RANK
IN_SPLITS = (ATT_WIDTH, ATT_KV_WIDTH, ATT_KV_WIDTH, ATT_WIDTH, RWKV_SHIFT_WIDTH, RWKV_WIDTH)
IN_WIDTH = ATT_WIDTH + 2 * ATT_KV_WIDTH + ATT_WIDTH + RWKV_SHIFT_WIDTH + RWKV_WIDTH
DECAY_SCALE = 0.6065306597126334
NORM_EPS = 1e-6
GN_EPS = 64e-5
L2_EPS = 1e-12

kernel_name = "hybrid_gqa_rwkv7_parallel_heads"


def rms_norm(x, g, eps=NORM_EPS):
    xf = x.astype(jnp.float32)
    y = xf * lax.rsqrt(jnp.mean(xf * xf, axis=-1, keepdims=True) + eps)
    return (y * g.astype(jnp.float32)).astype(x.dtype)


def axial_rope_tables(T, dtype):
    rows = T // GRID_W
    row = jnp.repeat(jnp.arange(rows, dtype=jnp.float32), GRID_W)
    col = jnp.tile(jnp.arange(GRID_W, dtype=jnp.float32), rows)
    n_freq = HEAD_DIM // 4
    inv_freq = ROPE_THETA ** (-jnp.arange(n_freq, dtype=jnp.float32) / n_freq)
    ang_r = row[:, None, None] * inv_freq
    ang_c = col[:, None, None] * inv_freq
    return (jnp.cos(ang_r).astype(dtype), jnp.sin(ang_r).astype(dtype),
            jnp.cos(ang_c).astype(dtype), jnp.sin(ang_c).astype(dtype))


def rotate_axis(x, cos, sin):
    n = x.shape[-1] // 2
    x1, x2 = x[..., :n], x[..., n:]
    return jnp.concatenate([x1 * cos - x2 * sin, x2 * cos + x1 * sin], axis=-1)


def apply_axial_rope(x, tables):
    cos_r, sin_r, cos_c, sin_c = tables
    half = HEAD_DIM // 2
    return jnp.concatenate([rotate_axis(x[..., :half], cos_r, sin_r),
                            rotate_axis(x[..., half:], cos_c, sin_c)], axis=-1)


def axial_gqa_attention(q, k, v, q_norm_g, k_norm_g):
    B, T, _ = q.shape
    q = rms_norm(q.reshape(B, T, ATT_Q_HEADS, HEAD_DIM), q_norm_g)
    k = rms_norm(k.reshape(B, T, ATT_KV_HEADS, HEAD_DIM), k_norm_g)
    v = v.reshape(B, T, ATT_KV_HEADS, HEAD_DIM)
    tables = axial_rope_tables(T, q.dtype)
    q = apply_axial_rope(q, tables)
    k = apply_axial_rope(k, tables)
    n_blk = T // Q_BLOCK
    q_blocks = q.reshape(B, n_blk, Q_BLOCK, ATT_KV_HEADS, ATT_GROUP, HEAD_DIM).transpose(1, 0, 3, 4, 2, 5)
    k_t = k.transpose(0, 2, 1, 3)
    v_t = v.transpose(0, 2, 1, 3)
    scale = HEAD_DIM ** -0.5

    def attend(q_blk):
        s = jnp.einsum('bkgqd,bksd->bkgqs', q_blk, k_t).astype(jnp.float32) * scale
        p = jax.nn.softmax(s, axis=-1).astype(v_t.dtype)
        return jnp.einsum('bkgqs,bksd->bkgqd', p, v_t)

    o = lax.map(attend, q_blocks)
    return o.transpose(1, 0, 4, 2, 3, 5).reshape(B, T, ATT_WIDTH)


def centered_shift(x, taps):
    xp = jnp.pad(x, ((0, 0), (1, 1), (0, 0)))
    return taps[0] * xp[:, :-2] + taps[1] * xp[:, 1:-1] + taps[2] * xp[:, 2:]


def bidir_rwkv7(r, k, v, wd, ad, w_up, w0, a_up, a0, k_k, k_a, r_k, gn_w, gn_b):
    f32 = jnp.float32
    B, T, _ = r.shape
    H, N = RWKV_HEADS, HEAD_DIM
    rf, kf, vf = r.astype(f32), k.astype(f32), v.astype(f32)
    heads = lambda z: z.reshape(z.shape[:-1] + (H, N))
    w = jnp.exp(-DECAY_SCALE * jax.nn.sigmoid(
        w0.astype(f32)[:, None, None, :]
        + jnp.einsum('btr,zrc->zbtc', jnp.tanh(wd.astype(f32)), w_up.astype(f32))))
    a = jax.nn.sigmoid(a0.astype(f32)[:, None, None, :]
                       + jnp.einsum('btr,zrc->zbtc', ad.astype(f32), a_up.astype(f32)))
    kk = heads(kf * k_k.astype(f32))
    kk = kk * lax.rsqrt(jnp.sum(kk * kk, axis=-1, keepdims=True) + L2_EPS)
    kt = kf[None] * (1.0 + (a - 1.0) * k_a.astype(f32))
    akk = heads(a) * kk[None]

    both = lambda z: jnp.stack([z, z])

    def time_major(z):
        z = jnp.stack([z[0], jnp.flip(z[1], axis=1)])
        return jnp.moveaxis(z, 2, 0)

    xs = (time_major(heads(w)), time_major(heads(kt)), time_major(both(heads(vf))),
          time_major(both(heads(rf))), time_major(both(kk)), time_major(akk))
    S0 = jnp.zeros((N_DIRS, B, H, N, N), f32)

    def step(S, inp):
        w_t, k_t, v_t, r_t, kk_t, akk_t = inp
        S = (S * w_t[..., None, :]
             - jnp.einsum('zbhvk,zbhk->zbhv', S, kk_t)[..., None] * akk_t[..., None, :]
             + v_t[..., :, None] * k_t[..., None, :])
        return S, jnp.einsum('zbhvk,zbhk->zbhv', S, r_t)

    _, ys = lax.scan(step, S0, xs)
    ys = jnp.moveaxis(ys, 0, 2)
    y = ys[0] + jnp.flip(ys[1], axis=1)
    mu = jnp.mean(y, axis=-1, keepdims=True)
    var = jnp.mean((y - mu) ** 2, axis=-1, keepdims=True)
    y = (y - mu) * lax.rsqrt(var + GN_EPS) * heads(gn_w.astype(f32)) + heads(gn_b.astype(f32))
    bonus = jnp.einsum('bthn,zbthn,hn->bth', heads(rf), heads(kt), r_k.astype(f32))[..., None] * heads(vf)
    return (y + bonus).reshape(B, T, RWKV_WIDTH)


def setup_inputs(seed: int = 0) -> dict:
    key = jax.random.key(seed)
    ks = jax.random.split(key, 24)
    L, D = DEPTH, D_MODEL
    nrm = jax.random.normal
    x = nrm(ks[0], (BATCH, SEQ, D), jnp.float32)
    c = nrm(ks[1], (BATCH, D), jnp.float32)
    w_ada = nrm(ks[2], (L, D, 3 * D), jnp.float32) * D ** -0.5
    b_ada = 0.01 * nrm(ks[3], (L, 3 * D), jnp.float32)
    g_pre = 1.0 + 0.05 * nrm(ks[4], (L, D), jnp.float32)
    w_in = nrm(ks[5], (L, D, IN_WIDTH), jnp.float32) * D ** -0.5
    q_norm_g = 1.0 + 0.05 * nrm(ks[6], (L, HEAD_DIM), jnp.float32)
    k_norm_g = 1.0 + 0.05 * nrm(ks[7], (L, HEAD_DIM), jnp.float32)
    shift_taps = (jnp.array([0.25, 1.0, 0.25], jnp.float32)[None, :, None]
                  + 0.05 * nrm(ks[8], (L, 3, RWKV_SHIFT_WIDTH), jnp.float32))
    w_up = 0.1 * nrm(ks[9], (L, N_DIRS, DECAY_RANK, RWKV_WIDTH), jnp.float32)
    w0 = jax.random.uniform(ks[10], (L, N_DIRS, RWKV_WIDTH), jnp.float32, -3.0, 3.0)
    a_up = 0.1 * nrm(ks[11], (L, N_DIRS, ICLR_RANK, RWKV_WIDTH), jnp.float32)
    a0 = 0.5 * nrm(ks[12], (L, N_DIRS, RWKV_WIDTH), jnp.float32)
    k_k = 0.85 + 0.05 * nrm(ks[13], (L, RWKV_WIDTH), jnp.float32)
    k_a = 1.0 + 0.05 * nrm(ks[14], (L, RWKV_WIDTH), jnp.float32)
    r_k = 0.1 * nrm(ks[15], (L, RWKV_HEADS, HEAD_DIM), jnp.float32)
    gn_w = 1.0 + 0.05 * nrm(ks[16], (L, RWKV_WIDTH), jnp.float32)
    gn_b = 0.01 * nrm(ks[17], (L, RWKV_WIDTH), jnp.float32)
    w_out = nrm(ks[18], (L, D_MIX, D), jnp.float32) * D_MIX ** -0.5
    g_post = 1.0 + 0.05 * nrm(ks[19], (L, D), jnp.float32)
    return {"x": x, "c": c, "w_ada": w_ada, "b_ada": b_ada, "g_pre": g_pre, "w_in": w_in,
            "q_norm_g": q_norm_g, "k_norm_g": k_norm_g, "shift_taps": shift_taps,
            "w_up": w_up, "w0": w0, "a_up": a_up, "a0": a0, "k_k": k_k, "k_a": k_a,
            "r_k": r_k, "gn_w": gn_w, "gn_b": gn_b, "w_out": w_out, "g_post": g_post}


def reference(x, c, w_ada, b_ada, g_pre, w_in, q_norm_g, k_norm_g, shift_taps,
              w_up, w0, a_up, a0, k_k, k_a, r_k, gn_w, gn_b, w_out, g_post):
    split_idx = [int(i) for i in np.cumsum(IN_SPLITS)[:-1]]
    rwkv_idx = [RWKV_WIDTH, 2 * RWKV_WIDTH, 3 * RWKV_WIDTH, 3 * RWKV_WIDTH + DECAY_RANK]
    c_act = jax.nn.silu(c)
    for l in range(DEPTH):
        mod = jnp.einsum('bd,de->be', c_act, w_ada[l]) + b_ada[l]
        shift, scale, gate = jnp.split(mod, 3, axis=-1)
        h = rms_norm(x, g_pre[l]) * (1.0 + scale[:, None, :]) + shift[:, None, :]
        proj = jnp.einsum('btd,dp->btp', h, w_in[l])
        q, k, v, g_att, rwkv_in, g_rwkv = jnp.split(proj, split_idx, axis=-1)
        y_att = axial_gqa_attention(q, k, v, q_norm_g[l], k_norm_g[l])
        rwkv_in = centered_shift(rwkv_in, shift_taps[l])
        r, kr, vr, wd, ad = jnp.split(rwkv_in, rwkv_idx, axis=-1)
        y_rwkv = bidir_rwkv7(r, kr, vr, wd, ad, w_up[l], w0[l], a_up[l], a0[l],
                             k_k[l], k_a[l], r_k[l], gn_w[l], gn_b[l]).astype(x.dtype)
        mixed = jnp.concatenate([y_att * jax.nn.silu(g_att), y_rwkv * jax.nn.silu(g_rwkv)], axis=-1)
        out = jnp.einsum('btm,md->btd', mixed, w_out[l])
        x = x + gate[:, None, :] * rms_norm(out, g_post[l])
    return x
```

```cpp
#include <hip/hip_runtime.h>
#include <cstdio>
#include <cstdint>
namespace pg8 {
#define PG8_LAS __attribute__((address_space(3)))
typedef unsigned short bf16_t;
typedef short bf16x8 __attribute__((ext_vector_type(8)));
typedef float f32x4 __attribute__((ext_vector_type(4)));
typedef unsigned u32x4 __attribute__((ext_vector_type(4)));
constexpr int BM = 256, BK = 64, HALF = 128, HTB = HALF * BK * 2  , STAGE_BYTES = 8 * HTB, NXCD = 8, WGM = 8;

__host__ __device__ __forceinline__ int lds_byte(int r, int c) { const int st = (r >> 4) * 2 + (c >> 5), rr = r & 15, cc = c & 31, ob = rr * 64 + cc * 2; return st * 1024 + (ob ^ (((ob >> 9) & 1) << 5)); }
__host__ __device__ __forceinline__ void stage_rc(int b, int& R, int& C) { const int st = b / 1024, sb = b % 1024, swz = sb ^ (((sb >> 9) & 1) << 5); R = (st >> 1) * 16 + swz / 64; C = (st & 1) * 32 + (swz % 64) / 2; }
__host__ __device__ __forceinline__ int perm32(int rho) { const int n = rho >> 4, i = rho & 15; return 8 * (i >> 2) + 4 * n + (i & 3); }

struct Unit { int pm, pn; };
struct Gemm { const bf16_t* A; const bf16_t* Bt; int M, N, K; };

struct StaticOrder {
    int nM, nN, nwg, G, c;
    __host__ __device__ void init(int M, int N, int G_, int c_) { nM = M / BM; nN = N / BM; nwg = nM * nN; G = G_; c = c_; }
    __host__ __device__ bool next(int i, Unit& u) const {
        const long L = (long)i * G + c; if (L >= nwg) return false;
        int wgid = (int)L; { const int q = nwg / NXCD, r = nwg % NXCD, xcd = wgid % NXCD, off = wgid / NXCD; wgid = (xcd < r ? xcd * (q + 1) : r * (q + 1) + (xcd - r) * q) + off; }
        const int nig = WGM * nN, gid = wgid / nig, fm = gid * WGM, gsz = (nM - fm) < WGM ? (nM - fm) : WGM;
        u.pm = fm + ((wgid % nig) % gsz); u.pn = (wgid % nig) / gsz; return true;
    }
    __device__ __forceinline__ void a_ready(const Unit&) const {}
    __device__ __forceinline__ void done(const Unit&) const {}
};

__device__ __forceinline__ unsigned cvt_pk_bf16(float lo, float hi) { unsigned r; asm volatile("v_cvt_pk_bf16_f32 %0, %1, %2" : "=v"(r) : "v"(lo), "v"(hi)); return r; }
template <class Epi, class Sched, bool ALIGN_EPI = false, bool SP2 = false>
__device__ __forceinline__ void gemm_phase(PG8_LAS unsigned char* lds, const Gemm g, const Sched& S, const Epi& E) {
    const int tid = threadIdx.x, wid = __builtin_amdgcn_readfirstlane(tid >> 6), lane = tid & 63, wr = wid >> 2, wc = wid & 3, fr = lane & 15, fq = lane >> 4;
    const int K = g.K, nt = K / BK;
    unsigned voffA[2], voffB[2];
#pragma unroll
    for (int i = 0; i < 2; ++i) { int R, C; stage_rc(tid * 16 + i * 8192, R, C); const int Rb = Epi::PERM ? ((R & ~31) + perm32(R & 31)) : R;
        voffA[i] = (unsigned)(R * K + C) * 2u; voffB[i] = (unsigned)(Rb * K + C) * 2u; }
    const size_t kstep = (size_t)(BK * 2);
    const size_t hstep = (size_t)HALF * K * 2;
    const size_t tstep = 2 * hstep;
    const unsigned ldsw = (unsigned)wid * 1024u;
    const int aoff = lds_byte(wr * 64 + fr, fq * 8), boff = lds_byte(wc * 32 + fr, fq * 8);
#define PG8_SA(b, h) (((b) * 2 + (h)) * HTB)
#define PG8_SB(b, h) ((4 + (b) * 2 + (h)) * HTB)
#define PG8_STAGE(bufoff, gbase, voff) do { _Pragma("unroll") for (int _i = 0; _i < 2; ++_i) \
        __builtin_amdgcn_global_load_lds((const unsigned*)((const char*)(gbase) + (voff)[_i]), (PG8_LAS unsigned*)(lds + (bufoff) + ldsw + _i * 8192), 16, 0, 0); } while (0)
#define PG8_LDA(dst, b, h) do { _Pragma("unroll") for (int m = 0; m < 4; ++m) _Pragma("unroll") for (int k = 0; k < 2; ++k) dst[m][k] = *(const PG8_LAS bf16x8*)(lds + PG8_SA(b, h) + aoff + m * 2048 + k * 1024); } while (0)
#define PG8_LDB(dst, b, h) do { _Pragma("unroll") for (int n = 0; n < 2; ++n) _Pragma("unroll") for (int k = 0; k < 2; ++k) dst[n][k] = *(const PG8_LAS bf16x8*)(lds + PG8_SB(b, h) + boff + n * 2048 + k * 1024); } while (0)
#define PG8_MMA(ai, bj, At, Bt) do { __builtin_amdgcn_s_setprio(1); _Pragma("unroll") for (int m = 0; m < 4; ++m) _Pragma("unroll") for (int n = 0; n < 2; ++n) _Pragma("unroll") for (int k = 0; k < 2; ++k) \
        acc[ai][bj][m][n] = __builtin_amdgcn_mfma_f32_16x16x32_bf16(Bt[n][k], At[m][k], acc[ai][bj][m][n], 0, 0, 0); __builtin_amdgcn_s_setprio(0); } while (0)
#define PG8_WAIT_V(n) asm volatile("s_waitcnt vmcnt(" #n ")" ::: "memory")
#define PG8_WAIT_L(n) asm volatile("s_waitcnt lgkmcnt(" #n ")" ::: "memory")
#define PG8_BAR __builtin_amdgcn_s_barrier()
#define PG8_SCHED __builtin_amdgcn_sched_barrier(0)
    Unit cur, nxt; int ui = 0;
    if (!S.next(0, cur)) return;
    f32x4 acc[2][2][4][2];
#pragma unroll
    for (int a = 0; a < 2; ++a)
#pragma unroll
        for (int b = 0; b < 2; ++b)
#pragma unroll
            for (int m = 0; m < 4; ++m)
#pragma unroll
                for (int n = 0; n < 2; ++n) acc[a][b][m][n] = (f32x4){0.f, 0.f, 0.f, 0.f};
    bf16x8 At[4][2], B0[2][2], B1[2][2];
    const char* cA = (const char*)g.A + (size_t)cur.pm * tstep; const char* cB = (const char*)g.Bt + (size_t)cur.pn * tstep;
    S.a_ready(cur);
    if constexpr (SP2) {
        PG8_STAGE(PG8_SB(0, 0), cB, voffB); PG8_STAGE(PG8_SB(0, 1), cB + hstep, voffB); PG8_STAGE(PG8_SA(0, 0), cA, voffA); PG8_STAGE(PG8_SA(0, 1), cA + hstep, voffA);
        if (wr == 1) PG8_BAR;
        PG8_WAIT_V(2); PG8_BAR;
        PG8_STAGE(PG8_SB(1, 0), cB + kstep, voffB); PG8_STAGE(PG8_SA(1, 0), cA + kstep, voffA); PG8_STAGE(PG8_SB(1, 1), cB + hstep + kstep, voffB);
        PG8_WAIT_V(6); PG8_BAR;
    } else {
        PG8_STAGE(PG8_SB(0, 0), cB, voffB); PG8_STAGE(PG8_SA(0, 0), cA, voffA); PG8_STAGE(PG8_SB(0, 1), cB + hstep, voffB); PG8_STAGE(PG8_SA(0, 1), cA + hstep, voffA);
        if (wr == 1) PG8_BAR;
        PG8_WAIT_V(4); PG8_BAR;
        PG8_STAGE(PG8_SB(1, 0), cB + kstep, voffB); PG8_STAGE(PG8_SA(1, 0), cA + kstep, voffA); PG8_STAGE(PG8_SB(1, 1), cB + hstep + kstep, voffB);
        PG8_WAIT_V(6); PG8_BAR;
    }
    for (;;) {
        const bool has_next = S.next(ui + 1, nxt);
        const char* nA = has_next ? (const char*)g.A + (size_t)nxt.pm * tstep : cA; const char* nB = has_next ? (const char*)g.Bt + (size_t)nxt.pn * tstep : cB;
        for (int t = 0; t < nt; t += 2) {
            const bool last = (t == nt - 2);
            const char* a1 = cA + (size_t)(t + 1) * kstep;
            const char* a2 = last ? nA : cA + (size_t)(t + 2) * kstep; const char* b2 = last ? nB : cB + (size_t)(t + 2) * kstep;
            const char* a3 = a2 + kstep; const char* b3 = b2 + kstep;
            if (last && has_next) S.a_ready(nxt);
            if constexpr (SP2) {
            PG8_LDB(B0, 0, 0); PG8_LDB(B1, 0, 1); PG8_SCHED; PG8_LDA(At, 0, 0); PG8_STAGE(PG8_SA(1, 1), a1 + hstep, voffA);
            PG8_WAIT_V(8); PG8_WAIT_L(0); PG8_BAR; PG8_MMA(0, 0, At, B0); PG8_MMA(0, 1, At, B1); PG8_BAR; PG8_SCHED;
            PG8_LDA(At, 0, 1); PG8_STAGE(PG8_SB(0, 0), b2, voffB); PG8_STAGE(PG8_SB(0, 1), b2 + hstep, voffB); PG8_STAGE(PG8_SA(0, 0), a2, voffA);
            PG8_WAIT_V(8); PG8_WAIT_L(0); PG8_BAR; PG8_MMA(1, 0, At, B0); PG8_MMA(1, 1, At, B1); PG8_BAR; PG8_SCHED;
            PG8_LDB(B0, 1, 0); PG8_LDB(B1, 1, 1); PG8_SCHED; PG8_LDA(At, 1, 0); PG8_STAGE(PG8_SA(0, 1), a2 + hstep, voffA);
            PG8_WAIT_V(8); PG8_WAIT_L(0); PG8_BAR; PG8_MMA(0, 0, At, B0); PG8_MMA(0, 1, At, B1); PG8_BAR; PG8_SCHED;
            PG8_LDA(At, 1, 1); PG8_STAGE(PG8_SB(1, 0), b3, voffB); PG8_STAGE(PG8_SB(1, 1), b3 + hstep, voffB); PG8_STAGE(PG8_SA(1, 0), a3, voffA);
            PG8_WAIT_V(8); PG8_WAIT_L(0); PG8_BAR; PG8_MMA(1, 0, At, B0); PG8_MMA(1, 1, At, B1); PG8_BAR; PG8_SCHED;
            } else {
            PG8_LDB(B0, 0, 0); PG8_SCHED; PG8_LDA(At, 0, 0); PG8_STAGE(PG8_SA(1, 1), a1 + hstep, voffA);
            PG8_WAIT_L(8); PG8_BAR; PG8_WAIT_L(0); PG8_MMA(0, 0, At, B0); PG8_BAR; PG8_SCHED;
            PG8_LDB(B1, 0, 1); PG8_STAGE(PG8_SB(0, 0), b2, voffB);
            PG8_BAR; PG8_WAIT_L(0); PG8_MMA(0, 1, At, B1); PG8_BAR;
            PG8_LDA(At, 0, 1); PG8_STAGE(PG8_SA(0, 0), a2, voffA);
            PG8_BAR; PG8_WAIT_L(0); PG8_MMA(1, 0, At, B0); PG8_BAR; PG8_SCHED;
            PG8_STAGE(PG8_SB(0, 1), b2 + hstep, voffB);
            PG8_WAIT_V(6); PG8_BAR; PG8_MMA(1, 1, At, B1); PG8_BAR;
            PG8_LDB(B0, 1, 0); PG8_SCHED; PG8_LDA(At, 1, 0); PG8_STAGE(PG8_SA(0, 1), a2 + hstep, voffA);
            PG8_WAIT_L(8); PG8_BAR; PG8_WAIT_L(0); PG8_MMA(0, 0, At, B0); PG8_BAR; PG8_SCHED;
            PG8_LDB(B1, 1, 1); PG8_STAGE(PG8_SB(1, 0), b3, voffB);
            PG8_BAR; PG8_WAIT_L(0); PG8_MMA(0, 1, At, B1); PG8_BAR;
            PG8_LDA(At, 1, 1); PG8_STAGE(PG8_SA(1, 0), a3, voffA);
            PG8_BAR; PG8_WAIT_L(0); PG8_MMA(1, 0, At, B0); PG8_BAR; PG8_SCHED;
            PG8_STAGE(PG8_SB(1, 1), b3 + hstep, voffB);
            PG8_WAIT_V(6); PG8_BAR; PG8_MMA(1, 1, At, B1); PG8_BAR;
            }
        }
        if constexpr (ALIGN_EPI) { if (wr == 0) PG8_BAR; }
        if constexpr (!Epi::AFTER_DRAIN) { E(acc, cur, wr, wc, fr, fq); S.done(cur); }
        if (!has_next) break;
#pragma unroll
        for (int a = 0; a < 2; ++a)
#pragma unroll
            for (int b = 0; b < 2; ++b)
#pragma unroll
                for (int m = 0; m < 4; ++m)
#pragma unroll
                    for (int n = 0; n < 2; ++n) acc[a][b][m][n] = (f32x4){0.f, 0.f, 0.f, 0.f};
        cur = nxt; cA = nA; cB = nB; ++ui;
        if constexpr (ALIGN_EPI) { if (wr == 1) PG8_BAR; }
    }
    PG8_WAIT_V(0);
    if constexpr (!ALIGN_EPI) { if (wr == 0) PG8_BAR; }
    PG8_BAR;
    if constexpr (Epi::AFTER_DRAIN) { E.fused(acc, cur, wr, wc, fr, fq, lds, wid, lane); S.done(cur); }
#undef PG8_SA
#undef PG8_SB
#undef PG8_STAGE
#undef PG8_LDA
#undef PG8_LDB
#undef PG8_MMA
#undef PG8_WAIT_V
#undef PG8_WAIT_L
#undef PG8_BAR
#undef PG8_SCHED
}
}
#ifndef PG8_SP2
#define PG8_SP2 true
#endif
#ifndef PG8_ALIGN
#define PG8_ALIGN true
#endif
#include <hip/hip_bf16.h>
#include <cmath>
namespace attn_body {
using bf16=__hip_bfloat16;
using bf16x8=__attribute__((ext_vector_type(8)))short;
using s16x4=__attribute__((ext_vector_type(4)))short;
using f32x16=__attribute__((ext_vector_type(16)))float;
using u32x4=__attribute__((ext_vector_type(4)))unsigned;
constexpr int BATCH=16,NHEAD=8,GQA=4,SEQ=2048,D=64;
constexpr int QP=512,KP=128,GP=512,OP=1024;
constexpr int NW=8,QBLK=32,QB=QBLK*NW,KVBLK=64,NQB=SEQ/QB;
__device__ __forceinline__ int crow(int r,int hi){return (r&3)+8*(r>>2)+4*hi;}
#define SBAR() __builtin_amdgcn_sched_barrier(0)
constexpr int NSLOT=3, SLOTB=8192;
constexpr int LDS_K=0, LDS_V=NSLOT*SLOTB, LDS_WS=2*NSLOT*SLOTB, LDS_OST=LDS_WS+NW*64*4, LDS_BYTES=LDS_OST+NW*4096;
constexpr float C2=0.125f*1.4426950408889634f;
__device__ __forceinline__ void glds16(const void*gsrc,unsigned lds_dst){unsigned keep;
  asm volatile("s_mov_b32 %0, m0\n\ts_mov_b32 m0, %2\n\ts_nop 0\n\tglobal_load_lds_dwordx4 %1, off\n\ts_mov_b32 m0, %0":"=&s"(keep):"v"(gsrc),"s"(lds_dst):"memory");}
__device__ __forceinline__ float max3f(float a,float b,float c){float r;asm("v_max3_f32 %0, %1, %2, %3":"=v"(r):"v"(a),"v"(b),"v"(c));return r;}
__device__ __forceinline__ float max2f(float a,float b){float r;asm("v_max_f32_e32 %0, %1, %2":"=v"(r):"v"(a),"v"(b));return r;}
__device__ __forceinline__ float fadd_s(float a,float b){float r;asm("v_add_f32_e32 %0, %1, %2":"=v"(r):"v"(a),"v"(b));return r;}
__device__ __forceinline__ float fsub_s(float a,float b){float r;asm("v_sub_f32_e32 %0, %1, %2":"=v"(r):"v"(a),"v"(b));return r;}
typedef float f32x2_t __attribute__((ext_vector_type(2))); typedef __bf16 bf16x2_t __attribute__((ext_vector_type(2)));
__device__ __forceinline__ unsigned cvtpk_s(float lo,float hi){f32x2_t v={lo,hi};bf16x2_t b=__builtin_convertvector(v,bf16x2_t);return __builtin_bit_cast(unsigned,b);}
#define WAIT_BAR(N) asm volatile("s_waitcnt vmcnt(" #N ") lgkmcnt(0)\n\ts_barrier":::"memory")

__device__ __forceinline__ void qkt(f32x16&p0,f32x16&p1,const char*Kslot,const bf16x8*qr,const f32x16&negm,int r32,int hi){
  const char*kb=Kslot+hi*1024+r32*16;
  #pragma unroll
  for(int d0=0;d0<4;++d0){
    const bf16x8 b0=*reinterpret_cast<const bf16x8*>(kb+d0*2048);
    const bf16x8 b1=*reinterpret_cast<const bf16x8*>(kb+d0*2048+512);
    if(d0==0){p0=__builtin_amdgcn_mfma_f32_32x32x16_bf16(b0,qr[0],negm,0,0,0);p1=__builtin_amdgcn_mfma_f32_32x32x16_bf16(b1,qr[0],negm,0,0,0);}
    else{p0=__builtin_amdgcn_mfma_f32_32x32x16_bf16(b0,qr[d0],p0,0,0,0);p1=__builtin_amdgcn_mfma_f32_32x32x16_bf16(b1,qr[d0],p1,0,0,0);}}
}
typedef __attribute__((address_space(3))) const char* lds_cptr;
typedef short v4i16_t __attribute__((ext_vector_type(4)));
__device__ __forceinline__ void kload8(bf16x8*kf,lds_cptr kp){
  kf[0]=*(const __attribute__((address_space(3))) bf16x8*)(kp);      kf[1]=*(const __attribute__((address_space(3))) bf16x8*)(kp+512);
  kf[2]=*(const __attribute__((address_space(3))) bf16x8*)(kp+2048); kf[3]=*(const __attribute__((address_space(3))) bf16x8*)(kp+2560);
  kf[4]=*(const __attribute__((address_space(3))) bf16x8*)(kp+4096); kf[5]=*(const __attribute__((address_space(3))) bf16x8*)(kp+4608);
  kf[6]=*(const __attribute__((address_space(3))) bf16x8*)(kp+6144); kf[7]=*(const __attribute__((address_space(3))) bf16x8*)(kp+6656);
}
__device__ __forceinline__ void kload2(bf16x8*kf,lds_cptr kp,int j){ kf[2*j]=*(const __attribute__((address_space(3))) bf16x8*)(kp+j*2048); kf[2*j+1]=*(const __attribute__((address_space(3))) bf16x8*)(kp+j*2048+512); }
__device__ __forceinline__ s16x4 vtr(lds_cptr p){ return __builtin_bit_cast(s16x4,__builtin_amdgcn_ds_read_tr16_b64_v4i16((__attribute__((address_space(3))) v4i16_t*)p)); }
__device__ __forceinline__ float rowmax(const f32x16&p0,const f32x16&p1){
  float a=max3f(p0[0],p0[1],p1[0]),b=max3f(p0[2],p0[3],p1[1]);a=max3f(a,p1[2],p1[3]);
  #pragma unroll
  for(int r=4;r<16;r+=4){a=max3f(a,p0[r],p0[r+1]);b=max3f(b,p0[r+2],p0[r+3]);a=max3f(a,p1[r],p1[r+1]);b=max3f(b,p1[r+2],p1[r+3]);}
  const float m=max2f(a,b);
  auto rr=__builtin_amdgcn_permlane32_swap(__float_as_uint(m),__float_as_uint(m),false,false);
  return max2f(__uint_as_float(rr[0]),__uint_as_float(rr[1]));
}
__device__ __forceinline__ void pv(f32x16*o,int vb,bf16x8 pa0,bf16x8 pa1,bf16x8 pa2,bf16x8 pa3){
  #pragma unroll
  for(int d0=0;d0<2;++d0){s16x4 lo[4],hi[4];
    #pragma unroll
    for(int ks=0;ks<4;++ks){
      asm volatile("ds_read_b64_tr_b16 %0,%1 offset:%c2":"=&v"(lo[ks]):"v"(vb),"i"(d0*4096+ks*1024):"memory");
      asm volatile("ds_read_b64_tr_b16 %0,%1 offset:%c2":"=&v"(hi[ks]):"v"(vb),"i"(d0*4096+ks*1024+512):"memory");}
    asm volatile("s_waitcnt lgkmcnt(0)":::"memory");SBAR();
    #define PK(k) (bf16x8){lo[k][0],lo[k][1],lo[k][2],lo[k][3],hi[k][0],hi[k][1],hi[k][2],hi[k][3]}
    o[d0]=__builtin_amdgcn_mfma_f32_32x32x16_bf16(pa0,PK(0),o[d0],0,0,0);
    o[d0]=__builtin_amdgcn_mfma_f32_32x32x16_bf16(pa1,PK(1),o[d0],0,0,0);
    o[d0]=__builtin_amdgcn_mfma_f32_32x32x16_bf16(pa2,PK(2),o[d0],0,0,0);
    o[d0]=__builtin_amdgcn_mfma_f32_32x32x16_bf16(pa3,PK(3),o[d0],0,0,0);
    #undef PK
  }
}
#ifndef ATTN_STORE16
#define ATTN_STORE16(p,v) (*(u32x4*)(p)=(v))
#endif
template<int THRL> __device__ __forceinline__ void attn_unit(int b,int h,int qb,const bf16*Q,const bf16*__restrict__ K,const bf16*__restrict__ V,const bf16*__restrict__ G,bf16*O,char*shm){
  const int tid=threadIdx.x,lane=tid&63,r32=lane&31,hi=lane>>5; const int wid=__builtin_amdgcn_readfirstlane(tid>>6);
  const long rowbase=(long)b*SEQ; const int q0=qb*QB;
  const bf16*Qw=Q+(rowbase+q0+wid*QBLK)*QP+h*D; const int kvh=h/GQA;
  const bf16*Kh=K+rowbase*KP+kvh*D,*Vh=V+rowbase*KP+kvh*D;
  const unsigned lds0=(unsigned)(uintptr_t)shm;
  float*wsf=(float*)(shm+LDS_WS)+wid*64;
  const bf16*ksrc=Kh+(long)lane*KP+wid*8;
  const bf16*vsrc=Vh+(long)(16*(wid&3)+(lane>>2))*KP+(wid>>2)*32+(lane&3)*8;
  const unsigned kdst=lds0+LDS_K+wid*1024, vdst=lds0+LDS_V+wid*1024;
  #define DMA_K(t,slot) glds16(ksrc+(long)(t)*KVBLK*KP,(unsigned)__builtin_amdgcn_readfirstlane(kdst+(slot)))
  #define DMA_V(t,slot) glds16(vsrc+(long)(t)*KVBLK*KP,(unsigned)__builtin_amdgcn_readfirstlane(vdst+(slot)))
  const int vb0=(int)(lds0+LDS_V)+((lane>>4)&1)*32+(lane&3)*8+(4*hi+((lane&15)>>2))*64;
  const char*Kbase=shm+LDS_K; bf16x8 kf[8];
  const lds_cptr shm3=(lds_cptr)shm; const lds_cptr kp0=shm3+LDS_K+hi*1024+r32*16; const lds_cptr vp0=shm3+LDS_V+((lane>>4)&1)*32+(lane&3)*8+(4*hi+((lane&15)>>2))*64;
  constexpr int NT=SEQ/KVBLK;
  DMA_K(0,0);DMA_V(0,0);DMA_K(1,SLOTB);
  bf16x8 qr[4];
  #pragma unroll
  for(int d0=0;d0<4;++d0)qr[d0]=*reinterpret_cast<const bf16x8*>(&Qw[(long)r32*QP+d0*16+hi*8]);
  float mhat=0.f,l_reg=0.f;f32x16 o[2];o[0]=f32x16{};o[1]=f32x16{};f32x16 negm=f32x16{};asm volatile("":"+v"(negm));
  #define CMASK(P0,P1,t) do{}while(0)
  bool resc=false;
  #define START(P0,P1) do{ const float rm=rowmax(P0,P1); resc=false; \
    { const float dl=rm; mhat=fadd_s(mhat,dl); \
      _Pragma("unroll") for(int r=0;r<16;++r){P0[r]=fsub_s(P0[r],dl);P1[r]=fsub_s(P1[r],dl);} \
      _Pragma("unroll") for(int r=0;r<16;++r)negm[r]=-mhat; asm volatile("":"+v"(negm)); } \
    _Pragma("unroll") for(int r=0;r<16;++r)P0[r]=__builtin_amdgcn_exp2f(P0[r]); }while(0)
  #define RESC() do{ if(resc){ asm volatile("s_waitcnt lgkmcnt(0)":::"memory"); \
      _Pragma("unroll") for(int d_=0;d_<2;++d_) _Pragma("unroll") for(int r=0;r<16;++r)o[d_][r]*=wsf[crow(r,hi)]; } }while(0)
  f32x16 pA0,pA1,pB0,pB1;
  int sl_prev=0,sl_cur=0,sl_next=SLOTB;
  #define ROT() do{sl_prev=sl_cur;sl_cur=sl_next;sl_next=(sl_next==(NSLOT-1)*SLOTB)?0:sl_next+SLOTB;}while(0)
  DMA_K(2,2*SLOTB);
  WAIT_BAR(3);
  qkt(pA0,pA1,Kbase,qr,negm,r32,hi);asm volatile("s_nop 15\n\ts_nop 7":"+v"(pA0),"+v"(pA1));CMASK(pA0,pA1,0);
  START(pA0,pA1);
  _Pragma("unroll") for(int r=0;r<16;++r)pA1[r]=__builtin_amdgcn_exp2f(pA1[r]);
  WAIT_BAR(0);
  DMA_K(3,0);DMA_V(1,SLOTB);
  ROT();
  kload8(kf,kp0+sl_cur);
  WAIT_BAR(2);
  s16x4 vlo[8],vhi[8]; u32x4 pw0,pw1,pw2,pw3;
  #define PKW(P,B) cvtpk_s(P[B],P[B+1])
  #define PAF(k) __builtin_bit_cast(bf16x8,pw##k)
  #define VFR(i) (bf16x8){vlo[i][0],vlo[i][1],vlo[i][2],vlo[i][3],vhi[i][0],vhi[i][1],vhi[i][2],vhi[i][3]}
  #define PIN(x) asm volatile("":"+v"(x))
  #define MX3(a,b,c) __builtin_fmaxf(__builtin_fmaxf((a),(b)),(c))
  #define GAPA(MF,A0,A1,A2,A3,W0,W1,PW) do{ MF; sacc+=A0; sacc+=A1; sacc+=A2; sacc+=A3; PIN(sacc); W0; W1; PIN(PW); SBAR(); }while(0)
  #define EX(v) __builtin_amdgcn_exp2f(v)
  #define GAPB(MF,X,B) do{ MF; X[B]=EX(X[B]); X[B+1]=EX(X[B+1]); X[B+2]=EX(X[B+2]); X[B+3]=EX(X[B+3]); PIN(X); SBAR(); }while(0)
  #define VRD(i) do{ vlo[i]=vtr(vp_+(((i)>>2)*4096+((i)&3)*1024)); vhi[i]=vtr(vp_+(((i)>>2)*4096+((i)&3)*1024+512)); }while(0)
  #define KRD(G,j) do{ if(G){ kload2(kf,kp0+sl_next,j); SBAR(); } }while(0)
  #define STEP(C0,C1,P0,P1,t,GK,GV,GL) do{ SBAR(); \
    const lds_cptr vp_=vp0+sl_prev; \
    VRD(0); SBAR(); float sacc=(P0[0]+P0[1]); \
    GAPA(C0=__builtin_amdgcn_mfma_f32_32x32x16_bf16(kf[0],qr[0],negm,0,0,0), P0[2],P0[3],P0[4],P0[5],     pw0[0]=PKW(P0,0), pw0[1]=PKW(P0,2), pw0); \
    VRD(4); SBAR(); GAPA(C1=__builtin_amdgcn_mfma_f32_32x32x16_bf16(kf[1],qr[0],negm,0,0,0), P0[6],P0[7],P0[8],P0[9],     pw0[2]=PKW(P0,4), pw0[3]=PKW(P0,6), pw0); \
    VRD(1); SBAR(); GAPA(C0=__builtin_amdgcn_mfma_f32_32x32x16_bf16(kf[2],qr[1],C0,0,0,0),   P0[10],P0[11],P0[12],P0[13], pw1[0]=PKW(P0,8), pw1[1]=PKW(P0,10), pw1); \
    VRD(5); SBAR(); GAPA(C1=__builtin_amdgcn_mfma_f32_32x32x16_bf16(kf[3],qr[1],C1,0,0,0),   P0[14],P0[15],P1[0],P1[1],   pw1[2]=PKW(P0,12),pw1[3]=PKW(P0,14), pw1); \
    VRD(2); SBAR(); GAPA(C0=__builtin_amdgcn_mfma_f32_32x32x16_bf16(kf[4],qr[2],C0,0,0,0),   P1[2],P1[3],P1[4],P1[5],     pw2[0]=PKW(P1,0), pw2[1]=PKW(P1,2), pw2); \
    VRD(6); SBAR(); GAPA(C1=__builtin_amdgcn_mfma_f32_32x32x16_bf16(kf[5],qr[2],C1,0,0,0),   P1[6],P1[7],P1[8],P1[9],     pw2[2]=PKW(P1,4), pw2[3]=PKW(P1,6), pw2); \
    VRD(3); SBAR(); GAPA(C0=__builtin_amdgcn_mfma_f32_32x32x16_bf16(kf[6],qr[3],C0,0,0,0),   P1[10],P1[11],P1[12],P1[13], pw3[0]=PKW(P1,8), pw3[1]=PKW(P1,10), pw3); \
    VRD(7); SBAR(); GAPA(C1=__builtin_amdgcn_mfma_f32_32x32x16_bf16(kf[7],qr[3],C1,0,0,0),   P1[14],P1[15],0.f,0.f,       pw3[2]=PKW(P1,12),pw3[3]=PKW(P1,14), pw3); \
    l_reg+=sacc; \
    if(GK){DMA_K((t)+3,sl_cur);} if(GV){DMA_V((t)+1,sl_next);} \
    CMASK(C0,C1,t); \
    { float a=MX3(C0[0],C0[1],C1[0]),b=MX3(C0[2],C0[3],C1[1]); a=MX3(a,C1[2],C1[3]); \
      _Pragma("unroll") for(int r=4;r<16;r+=4){a=MX3(a,C0[r],C0[r+1]);b=MX3(b,C0[r+2],C0[r+3]);a=MX3(a,C1[r],C1[r+1]);b=MX3(b,C1[r+2],C1[r+3]);} \
      float rm=__builtin_fmaxf(a,b); { auto rr=__builtin_amdgcn_permlane32_swap(__float_as_uint(rm),__float_as_uint(rm),false,false); rm=__builtin_fmaxf(__uint_as_float(rr[0]),__uint_as_float(rr[1])); } \
      resc=false; \
      if(__builtin_expect(__any(rm>(float)THRL),0)){ const float dl=__builtin_fmaxf(rm,0.f); mhat+=dl; \
        _Pragma("unroll") for(int r=0;r<16;++r){C0[r]-=dl;C1[r]-=dl;} \
        _Pragma("unroll") for(int r=0;r<16;++r)negm[r]=-mhat; asm volatile("":"+v"(negm)); \
        const float f=__builtin_amdgcn_exp2f(-dl); l_reg*=f; if(hi==0)wsf[r32]=f; resc=true; } } \
    SBAR(); \
    GAPB(o[0]=__builtin_amdgcn_mfma_f32_32x32x16_bf16(PAF(0),VFR(0),o[0],0,0,0), C0,0); \
    GAPB(o[1]=__builtin_amdgcn_mfma_f32_32x32x16_bf16(PAF(0),VFR(4),o[1],0,0,0), C0,4); \
    KRD(GL,0); GAPB(o[0]=__builtin_amdgcn_mfma_f32_32x32x16_bf16(PAF(1),VFR(1),o[0],0,0,0), C0,8); \
    KRD(GL,1); GAPB(o[1]=__builtin_amdgcn_mfma_f32_32x32x16_bf16(PAF(1),VFR(5),o[1],0,0,0), C0,12); \
    KRD(GL,2); GAPB(o[0]=__builtin_amdgcn_mfma_f32_32x32x16_bf16(PAF(2),VFR(2),o[0],0,0,0), C1,0); \
    KRD(GL,3); GAPB(o[1]=__builtin_amdgcn_mfma_f32_32x32x16_bf16(PAF(2),VFR(6),o[1],0,0,0), C1,4); \
    GAPB(o[0]=__builtin_amdgcn_mfma_f32_32x32x16_bf16(PAF(3),VFR(3),o[0],0,0,0), C1,8); \
    GAPB(o[1]=__builtin_amdgcn_mfma_f32_32x32x16_bf16(PAF(3),VFR(7),o[1],0,0,0), C1,12); \
    }while(0)
  int t=1;
  #undef CMASK
  #define CMASK(P0,P1,t) do{}while(0)
  for(;t+5<NT;t+=2){
    STEP(pB0,pB1,pA0,pA1,t,true,true,true);     WAIT_BAR(2); RESC(); ROT();
    STEP(pA0,pA1,pB0,pB1,t+1,true,true,true);   WAIT_BAR(2); RESC(); ROT();
  }
  #undef CMASK
  #define CMASK(P0,P1,t) do{}while(0)
  #define ENDW(tt) do{ if((tt)+3<NT){WAIT_BAR(2);} else if((tt)+2<NT){WAIT_BAR(1);} else {WAIT_BAR(0);} }while(0)
  for(;t+1<NT;t+=2){
    STEP(pB0,pB1,pA0,pA1,t,(t+3<NT),(t+1<NT),(t+1<NT));       ENDW(t);   RESC(); ROT();
    STEP(pA0,pA1,pB0,pB1,t+1,(t+4<NT),(t+2<NT),(t+2<NT));     ENDW(t+1); RESC(); ROT();
  }
  STEP(pB0,pB1,pA0,pA1,NT-1,false,false,false); RESC();
  { float sacc=pB0[0]+pB0[1]; _Pragma("unroll") for(int r=2;r<16;++r)sacc+=pB0[r]; _Pragma("unroll") for(int r=0;r<16;++r)sacc+=pB1[r]; l_reg+=sacc;
    pw0=(u32x4){PKW(pB0,0),PKW(pB0,2),PKW(pB0,4),PKW(pB0,6)};pw1=(u32x4){PKW(pB0,8),PKW(pB0,10),PKW(pB0,12),PKW(pB0,14)};pw2=(u32x4){PKW(pB1,0),PKW(pB1,2),PKW(pB1,4),PKW(pB1,6)};pw3=(u32x4){PKW(pB1,8),PKW(pB1,10),PKW(pB1,12),PKW(pB1,14)};
    SBAR(); pv(o,vb0+sl_cur,PAF(0),PAF(1),PAF(2),PAF(3)); }
  #undef PKW
  #undef PAF
  #undef VFR
  #undef PIN
  #undef MX3
  #undef GAPA
  #undef GAPB
  #undef EX
  #undef VRD
  #undef KRD
  #undef STEP
  #undef ENDW
  {auto rr=__builtin_amdgcn_permlane32_swap(__float_as_uint(l_reg),__float_as_uint(l_reg),false,false);l_reg=__uint_as_float(rr[0])+__uint_as_float(rr[1]);}
  if(hi==0)wsf[32+r32]=l_reg;asm volatile("s_waitcnt lgkmcnt(0)":::"memory");
  float rli[16];
  #pragma unroll
  for(int r=0;r<16;++r)rli[r]=__builtin_amdgcn_rcpf(wsf[32+crow(r,hi)]);
  bf16*Ow=O+(rowbase+q0+wid*QBLK)*OP+h*D; const bf16*Gw=G+(rowbase+q0+wid*QBLK)*GP+h*D;
  { bf16*stg=(bf16*)(shm+LDS_OST)+wid*2048;
    #pragma unroll
    for(int r=0;r<16;++r){const int orow=crow(r,hi);
      #pragma unroll
      for(int d0=0;d0<2;++d0)stg[orow*64+d0*32+r32]=__float2bfloat16(o[d0][r]*rli[r]);}
    asm volatile("s_waitcnt lgkmcnt(0)":::"memory");
    #pragma unroll
    for(int i=0;i<4;++i){const int row=i*8+(lane>>3),ch=lane&7; const u32x4 v=*(const u32x4*)(stg+row*64+ch*8); const u32x4 g=*(const u32x4*)(Gw+(long)row*GP+ch*8); u32x4 w;
      #pragma unroll
      for(int e=0;e<4;++e){ const float a0=__uint_as_float(v[e]<<16)*__uint_as_float(g[e]<<16), a1=__uint_as_float(v[e]&0xffff0000u)*__uint_as_float(g[e]&0xffff0000u); w[e]=cvtpk_s(a0,a1);}
      ATTN_STORE16(Ow+(long)row*OP+ch*8,w);} }
  asm volatile("s_waitcnt lgkmcnt(0)\n\ts_barrier":::"memory");
  #undef DMA_K
  #undef DMA_V
  #undef CMASK
  #undef START
  #undef RESC
  #undef ROT
}
constexpr int ATTN_LDS_BYTES=LDS_BYTES;
struct AttnTensors { const bf16* Q; const bf16* K; const bf16* V; const bf16* G; bf16* O; };
struct AttnUnit { int bh; int qb; };
struct StaticOrder {
  int vcu, upc;
  __device__ __forceinline__ explicit StaticOrder(int grid,int block):vcu((grid%8==0)?(block%8)*(grid/8)+block/8:block),upc((BATCH*NHEAD*NQB+grid-1)/grid){}
  __device__ __forceinline__ bool next(int i,AttnUnit&u)const{ if(i>=upc)return false; const int x=vcu*upc+i; if(x>=BATCH*NHEAD*NQB)return false; u.qb=x%NQB; u.bh=x/NQB; return true; }
  __device__ __forceinline__ void a_ready(const AttnUnit&)const{}
  __device__ __forceinline__ void done(const AttnUnit&)const{}
};
template<class Sched,int THRL=8> __device__ __forceinline__ void attn_phase(char*lds,const AttnTensors&T,const Sched&S){
  AttnUnit u;
  for(int i=0;S.next(i,u);++i){ S.a_ready(u); attn_unit<THRL>(u.bh/NHEAD,u.bh%NHEAD,u.qb,T.Q,T.K,T.V,T.G,T.O,lds); S.done(u); }
}
#undef SBAR
#undef WAIT_BAR
}
constexpr int NWAVES = 8;
#ifndef MK_N_LAUNCHES
#define MK_N_LAUNCHES 1
#endif
constexpr int PER_PHASE = 7;
constexpr int N_LAUNCHES = MK_N_LAUNCHES;
static_assert(N_LAUNCHES == 1 || N_LAUNCHES == PER_PHASE, "MK_N_LAUNCHES is 1 or 7");

constexpr int BATCH = 16, T = 2048, D = 1024, HD = 64;
constexpr int M = BATCH * T;
constexpr int NIN = 3456, NINP = 3584;
constexpr int RW = 512, RSW = 1664;
constexpr float NORM_EPS = 1e-6f, GN_EPS = 64e-5f, L2_EPS = 1e-12f, DECAY_SCALE = 0.6065306597126334f;

constexpr size_t MiB = 1u << 20;
constexpr size_t WS_CTL = 0, CTL_ZERO_BYTES = 1 * MiB;
constexpr size_t WS_MOD = 512 * 1024;
constexpr size_t WS_ROPE = 1 * MiB;
constexpr size_t WS_WIN = 2 * MiB;
constexpr size_t WS_WOUT = 10 * MiB;
constexpr size_t WS_XCH = 12 * MiB;
constexpr size_t WS_BON = 14 * MiB;
constexpr size_t WS_XN = 16 * MiB;
constexpr size_t WS_Q = 80 * MiB, WS_K = 112 * MiB, WS_V = 120 * MiB;
constexpr size_t WS_GATT = 128 * MiB;
constexpr size_t WS_RKV = 160 * MiB;
constexpr size_t WS_WA = 256 * MiB;
constexpr size_t WS_GRW = 264 * MiB;
constexpr size_t WS_Y = 296 * MiB;
constexpr size_t WS_OUTPRE = 80 * MiB;
constexpr size_t WS_END = 424 * MiB;
constexpr int CW_TMO = 0, CW_CODE = 1;
constexpr int CW_BAR = 4096;
constexpr int CW_SEAM = 16384;

constexpr int RING_OFF = 0, RING_BYTES = 131072;
constexpr int LDSCTL_OFF = RING_BYTES, MISC_OFF = LDSCTL_OFF + 320;
constexpr int LDS_BYTES = 147456;
static_assert(MISC_OFF + 128 <= LDS_BYTES, "LDS map");
#define GAS __attribute__((address_space(1)))
#define LAS __attribute__((address_space(3)))
typedef unsigned short bf16;
typedef unsigned v4u __attribute__((ext_vector_type(4)));
typedef float f32x4 __attribute__((ext_vector_type(4)));
typedef short bf16x8 __attribute__((ext_vector_type(8)));
typedef GAS unsigned gu32;
typedef GAS unsigned long long gu64;
#define RLX_AGENT __ATOMIC_RELAXED, __HIP_MEMORY_SCOPE_AGENT
#define LDS_WAIT() asm volatile("s_waitcnt lgkmcnt(0)" ::: "memory")
#define VM_WAIT() asm volatile("s_waitcnt vmcnt(0)" ::: "memory")
__device__ __forceinline__ unsigned long long rt() { return __builtin_amdgcn_s_memrealtime(); }
__device__ __forceinline__ unsigned f2bf(float f) { unsigned u = __builtin_bit_cast(unsigned, f); return (u + 0x7fffu + ((u >> 16) & 1u)) >> 16; }
__device__ __forceinline__ unsigned pk2(float lo, float hi) { return f2bf(lo) | (f2bf(hi) << 16); }

#define XB_TMO      128
#define XB_XCNT(j)  (256  + 64 * (j))
#define XB_XSUB(j)  (1280 + 64 * (j))
#define XB_XGEN(j)  (2304 + 64 * (j))
#define XB_TOP      3328
#define XB_TOPGEN   3392
#define XCD_BAR_WORDS 3456
#define XB_SPIN_CAP (1u << 18)

__device__ __forceinline__ unsigned xb_ld(unsigned* p)              { return __hip_atomic_load(p, __ATOMIC_RELAXED, __HIP_MEMORY_SCOPE_AGENT); }
__device__ __forceinline__ unsigned xb_add(unsigned* p, unsigned v) { return __hip_atomic_fetch_add(p, v, __ATOMIC_RELAXED, __HIP_MEMORY_SCOPE_AGENT); }
__device__ __forceinline__ unsigned xb_xcc_id() { return (unsigned)__builtin_amdgcn_s_getreg((3 << 11) | 20) & 0xFu; }
#define XB_SPIN(cond, bar) do { unsigned _sp = 0; while (cond) { __builtin_amdgcn_s_sleep(1); \
    if ((++_sp & 255u) == 0u) { if (xb_ld(&(bar)[XB_TMO])) break; if (_sp > XB_SPIN_CAP) { atomicAdd(&(bar)[XB_TMO], 1u); break; } } } } while (0)

struct XcdBarrier {
    unsigned* bar; unsigned x;
    volatile LAS unsigned* st;
};

__device__ __forceinline__ XcdBarrier xcd_barrier_post(unsigned* bar, volatile LAS unsigned* st) {
    XcdBarrier b; b.bar = bar; b.x = xb_xcc_id(); b.st = st;
    if (threadIdx.x == 0) (void)xb_add(&bar[XB_XCNT(b.x)], 1u);
    return b;
}
__device__ __forceinline__ void xcd_barrier_complete(unsigned* bar, unsigned x, unsigned& nloc, unsigned& nx) {
    const unsigned G = gridDim.x * gridDim.y * gridDim.z;
    unsigned sum, cnt, mine, sp = 0u;
    for (;;) {
        sum = 0u; cnt = 0u; mine = 0u;
#pragma unroll
        for (unsigned j = 0; j < 16; ++j) { const unsigned c = xb_ld(&bar[XB_XCNT(j)]); sum += c; cnt += (c > 0u) ? 1u : 0u; mine = (j == x) ? c : mine; }
        if (sum == G) break;
        __builtin_amdgcn_s_sleep(1);
        if ((++sp & 255u) == 0u) { if (xb_ld(&bar[XB_TMO])) break; if (sp > XB_SPIN_CAP) { atomicAdd(&bar[XB_TMO], 1u); break; } }
    }
    nloc = mine > 0u ? mine : 1u; nx = cnt > 0u ? cnt : 1u;
}

__device__ __forceinline__ void xcd_barrier(const XcdBarrier& b) {
    asm volatile("s_waitcnt vmcnt(0)" ::: "memory");
    __syncthreads();
    if (threadIdx.x == 0) {
        unsigned* bar = b.bar;
        __builtin_amdgcn_s_waitcnt(0);
        unsigned nloc = b.st[0], nx = b.st[1];
        if (nloc == 0u) { xcd_barrier_complete(bar, b.x, nloc, nx); b.st[0] = nloc; b.st[1] = nx; }
        const unsigned old = xb_add(&bar[XB_XSUB(b.x)], 1u);
        const unsigned gen = old / nloc;
        if (old + 1u == (gen + 1u) * nloc) {
            __builtin_amdgcn_fence(__ATOMIC_RELEASE, "agent");
            asm volatile("s_waitcnt vmcnt(0)" ::: "memory");
            const unsigned og = xb_add(&bar[XB_TOP], 1u);
            const unsigned tg = og / nx;
            if (og + 1u == (tg + 1u) * nx) xb_add(&bar[XB_TOPGEN], 1u);
            else XB_SPIN(xb_ld(&bar[XB_TOPGEN]) == tg, bar);
            __builtin_amdgcn_fence(__ATOMIC_ACQUIRE, "agent");
            xb_add(&bar[XB_XGEN(b.x)], 1u);
            asm volatile("s_waitcnt vmcnt(0)" ::: "memory");
        } else {
            XB_SPIN(xb_ld(&bar[XB_XGEN(b.x)]) == gen, bar);
            __builtin_amdgcn_fence(__ATOMIC_ACQUIRE, "agent");
            asm volatile("s_waitcnt vmcnt(0)" ::: "memory");
        }
    }
    __syncthreads();
}
struct Frame {
    LAS unsigned char* lds;
    volatile LAS unsigned* MISC;
    gu32* ctl;
    int tid, lane, wave;
    int vcu, G;
    const float *x, *c, *w_ada, *b_ada, *g_pre, *w_in, *q_norm_g, *k_norm_g, *taps, *w_up, *w0, *a_up, *a0, *k_k, *k_a, *r_k, *gn_w, *gn_b, *w_out, *g_post;
    float* out;
    float *MOD, *ROPE, *BON, *Y, *OUTPRE;
    bf16 *Win_t, *Wout_t, *XN, *QB, *KB, *VB, *GATT, *RKV, *WA, *GRW, *MIX;
};

__device__ __forceinline__ float wave_sum(float v) {
#pragma unroll
    for (int o = 1; o < 64; o <<= 1) v += __shfl_xor(v, o);
    return v;
}
__device__ __forceinline__ float bf2f(bf16 v) { return __uint_as_float((unsigned)v << 16); }
__device__ __forceinline__ float sigmoidf_(float v) { return 1.0f / (1.0f + __expf(-v)); }
__device__ __forceinline__ float siluf_(float v) { return v / (1.0f + __expf(-v)); }

__device__ __forceinline__ int win_dest_row(int n) {
    if (n < 640) {
        const int hd = n >> 6, d = n & 63, tile = hd >> 2, wc = hd & 3, bj = d >> 5, dl = d & 31, nn = dl >> 4, fq = (dl >> 2) & 3, e = dl & 3;
        return tile * 256 + 128 * bj + 32 * wc + 8 * fq + 4 * nn + e;
    }
    if (n < 768) { const int j = n - 640, vh = j >> 6, d = j & 63; return 2 * 256 + 128 * (d >> 5) + 32 * (2 + vh) + (d & 31); }
    if (n < 1280) return 3 * 256 + (n - 768);
    if (n < 2816) return 5 * 256 + (n - 1280);
    if (n < 2944) return 11 * 256 + (n - 2816);
    return 12 * 256 + (n - 2944);
}
template <bool PERMUTE>
__device__ __forceinline__ void p0_transpose_item(const float* W, int K, int N, bf16* WT, LAS float* scr, int item, int lane) {
    const int nblk = N / 32, kb = item / nblk, nb = item % nblk, k0 = 64 * kb, n0 = 32 * nb;
#pragma unroll 8
    for (int i = 0; i < 32; ++i) { const int kk = 2 * i + (lane >> 5); scr[kk * 33 + (lane & 31)] = W[(size_t)(k0 + kk) * N + n0 + (lane & 31)]; }
    LDS_WAIT(); asm volatile("" ::: "memory");
    const int c = lane & 7;
#pragma unroll
    for (int j = 0; j < 4; ++j) { const int n = (lane >> 3) + 8 * j; const LAS float* s = scr + (8 * c) * 33 + n;
        v4u o; o.x = pk2(s[0 * 33], s[1 * 33]); o.y = pk2(s[2 * 33], s[3 * 33]); o.z = pk2(s[4 * 33], s[5 * 33]); o.w = pk2(s[6 * 33], s[7 * 33]);
        const int drow = PERMUTE ? win_dest_row(n0 + n) : (n0 + n);
        *(GAS v4u*)(WT + (size_t)drow * K + k0 + 8 * c) = o; }
    LDS_WAIT(); asm volatile("" ::: "memory");
}
__device__ __forceinline__ void p0_mod_item(Frame& F, LAS float* scr, int item) {
    const int cb = item >> 3, ks = item & 7, col = cb * 64 + F.lane, k0 = ks * 128;
    for (int i = F.lane; i < 16 * 128; i += 64) { const int b = i >> 7, k = i & 127; scr[i] = siluf_(F.c[b * D + k0 + k]); }
    LDS_WAIT(); asm volatile("" ::: "memory");
    float acc[16];
#pragma unroll
    for (int b = 0; b < 16; ++b) acc[b] = 0.f;
    for (int k = 0; k < 128; k += 4) {
        float w[4];
#pragma unroll
        for (int j = 0; j < 4; ++j) w[j] = F.w_ada[(size_t)(k0 + k + j) * (3 * D) + col];
#pragma unroll
        for (int b = 0; b < 16; ++b) { const f32x4 s = *(const LAS f32x4*)(scr + b * 128 + k); acc[b] += s[0] * w[0] + s[1] * w[1] + s[2] * w[2] + s[3] * w[3]; }
    }
    const float bias = (ks == 0) ? F.b_ada[col] : 0.f;
#pragma unroll
    for (int b = 0; b < 16; ++b) atomicAdd(F.MOD + b * (3 * D) + col, acc[b] + bias);
    LDS_WAIT(); asm volatile("" ::: "memory");
}
__device__ __forceinline__ void p0_prologue(Frame& F) {
    LAS float* scr = (LAS float*)(F.lds + RING_OFF + F.wave * 16384);
    const int gw = F.vcu * NWAVES + F.wave, NGW = F.G * NWAVES;
    constexpr int I_IN = (D / 64) * (NIN / 32), I_OUT = (D / 64) * (D / 32), I_MOD = 48 * 8;
    constexpr int NITEMS = I_IN + I_OUT + I_MOD;
    for (int it0 = gw; it0 < NITEMS; it0 += NGW) {
        int r = NITEMS - 1 - it0;
        if (r >= I_IN + I_OUT) { p0_mod_item(F, scr, r - I_IN - I_OUT); continue; }
        if (r < I_IN) { p0_transpose_item<true>(F.w_in, D, NIN, F.Win_t, scr, r, F.lane); continue; } r -= I_IN;
        p0_transpose_item<false>(F.w_out, D, D, F.Wout_t, scr, r, F.lane);
    }
    { const int gt = F.vcu * (NWAVES * 64) + F.tid, NGT = F.G * NWAVES * 64;
      for (int i = gt; i < 16384; i += NGT) *(GAS v4u*)(F.Win_t + (size_t)(11 * 256 + 128) * D + (size_t)i * 8) = (v4u){0u, 0u, 0u, 0u};
      for (int i = gt; i < 1024; i += NGT) { const int pos = i >> 4, fi = i & 15; const float inv = powf(10000.0f, -(float)fi / 16.0f); const float ang = (float)pos * inv;
          F.ROPE[i] = cosf(ang); F.ROPE[1024 + i] = sinf(ang); } }
}
__device__ __forceinline__ void p1_xn(Frame& F) {
    const int gw = F.vcu * NWAVES + F.wave, NGW = F.G * NWAVES;
    for (int grp = gw; grp < M / 16; grp += NGW) {
        const int m0 = grp * 16, b = m0 / T;
        f32x4 gs[4], sh[4];
#pragma unroll
        for (int j = 0; j < 4; ++j) { const int d0 = 256 * j + 4 * F.lane; const f32x4 g = *(const GAS f32x4*)(F.g_pre + d0), sc = *(const GAS f32x4*)(F.MOD + b * 3 * D + D + d0);
            gs[j] = g * (sc + 1.0f); sh[j] = *(const GAS f32x4*)(F.MOD + b * 3 * D + d0); }
        for (int r = 0; r < 16; ++r) {
            const GAS f32x4* xr = (const GAS f32x4*)(F.x + (size_t)(m0 + r) * D) + F.lane;
            f32x4 v[4]; float s = 0.f;
#pragma unroll
            for (int j = 0; j < 4; ++j) { v[j] = xr[64 * j]; s += (v[j].x * v[j].x + v[j].y * v[j].y) + (v[j].z * v[j].z + v[j].w * v[j].w); }
            const float rstd = 1.f / sqrtf(wave_sum(s) * (1.f / D) + NORM_EPS);
            GAS unsigned long long* o8 = (GAS unsigned long long*)(F.XN + (size_t)(m0 + r) * D) + F.lane;
#pragma unroll
            for (int j = 0; j < 4; ++j) { const f32x4 h = v[j] * rstd * gs[j] + sh[j];
                o8[64 * j] = (unsigned long long)pk2(h.x, h.y) | ((unsigned long long)pk2(h.z, h.w) << 32); }
        }
    }
}

struct EpiInProj {
    static constexpr bool PERM = true, AFTER_DRAIN = false;
    bf16 *Q, *K, *V, *GATT, *RKV, *WA, *GRW; const float *qg, *kg, *rope; float c2;
    __device__ __forceinline__ void operator()(const f32x4 (&acc)[2][2][4][2], const pg8::Unit& u, int wr, int wc, int fr, int fq) const {
        const int pn = u.pn, row0 = u.pm * 256 + wr * 64 + fr;
        if (pn >= 3) {
            bf16* base; int ldc, colt; bool act;
            if (pn < 5) { base = GATT; ldc = 512; colt = (pn - 3) * 256; act = true; }
            else if (pn < 11) { base = RKV; ldc = 1536; colt = (pn - 5) * 256; act = false; }
            else if (pn == 11) { base = WA; ldc = 128; colt = 0; act = false; }
            else { base = GRW; ldc = 512; colt = (pn - 12) * 256; act = true; }
            const int col0 = colt + wc * 32 + 8 * fq;
#pragma unroll
            for (int ai = 0; ai < 2; ++ai)
#pragma unroll
                for (int m = 0; m < 4; ++m) { bf16* rowp = base + (size_t)(row0 + ai * 128 + m * 16) * ldc + col0;
#pragma unroll
                    for (int bj = 0; bj < 2; ++bj) { if (pn == 11 && bj == 1) continue;
                        f32x4 v0 = acc[ai][bj][m][0], v1 = acc[ai][bj][m][1];
                        if (act) { v0 = (f32x4){siluf_(v0[0]), siluf_(v0[1]), siluf_(v0[2]), siluf_(v0[3])}; v1 = (f32x4){siluf_(v1[0]), siluf_(v1[1]), siluf_(v1[2]), siluf_(v1[3])}; }
                        v4u w; w.x = pg8::cvt_pk_bf16(v0[0], v0[1]); w.y = pg8::cvt_pk_bf16(v0[2], v0[3]); w.z = pg8::cvt_pk_bf16(v1[0], v1[1]); w.w = pg8::cvt_pk_bf16(v1[2], v1[3]);
                        *(v4u*)(rowp + bj * 128) = w; } }
        } else if (pn == 2 && wc >= 2) {
#pragma unroll
            for (int ai = 0; ai < 2; ++ai)
#pragma unroll
                for (int m = 0; m < 4; ++m) { bf16* rowp = V + (size_t)(row0 + ai * 128 + m * 16) * 128 + (wc - 2) * 64 + 8 * fq;
#pragma unroll
                    for (int bj = 0; bj < 2; ++bj) { const f32x4 v0 = acc[ai][bj][m][0], v1 = acc[ai][bj][m][1];
                        v4u w; w.x = pg8::cvt_pk_bf16(v0[0], v0[1]); w.y = pg8::cvt_pk_bf16(v0[2], v0[3]); w.z = pg8::cvt_pk_bf16(v1[0], v1[1]); w.w = pg8::cvt_pk_bf16(v1[2], v1[3]);
                        *(v4u*)(rowp + bj * 32) = w; } }
        } else {
            const bool isq = pn < 2; const float* g = isq ? qg : kg; const float sc = isq ? c2 : 1.0f;
            bf16* base = isq ? (Q + (pn * 4 + wc) * 64) : (K + wc * 64); const int ldc = isq ? 512 : 128;
            f32x4 gv[2][2];
#pragma unroll
            for (int bj = 0; bj < 2; ++bj)
#pragma unroll
                for (int n = 0; n < 2; ++n) gv[bj][n] = *(const f32x4*)(g + 32 * bj + 16 * n + 4 * fq);
#pragma unroll
            for (int ai = 0; ai < 2; ++ai)
#pragma unroll
                for (int m = 0; m < 4; ++m) { const int row = row0 + ai * 128 + m * 16, t = row & (T - 1);
                    float ss = 0.f;
#pragma unroll
                    for (int bj = 0; bj < 2; ++bj)
#pragma unroll
                        for (int n = 0; n < 2; ++n) { const f32x4 v = acc[ai][bj][m][n]; ss += (v[0] * v[0] + v[1] * v[1]) + (v[2] * v[2] + v[3] * v[3]); }
                    ss += __shfl_xor(ss, 16); ss += __shfl_xor(ss, 32);
                    const float rstd = sc / sqrtf(ss * (1.0f / 64.0f) + NORM_EPS);
#pragma unroll
                    for (int bj = 0; bj < 2; ++bj) { const int pos = bj ? (t & 63) : (t >> 6);
                        const f32x4 cs = *(const f32x4*)(rope + pos * 16 + 4 * fq), sn = *(const f32x4*)(rope + 1024 + pos * 16 + 4 * fq);
                        const f32x4 x1 = acc[ai][bj][m][0] * rstd * gv[bj][0], x2 = acc[ai][bj][m][1] * rstd * gv[bj][1];
                        const f32x4 y1 = x1 * cs - x2 * sn, y2 = x2 * cs + x1 * sn;
                        v4u w; w.x = pg8::cvt_pk_bf16(y1[0], y1[1]); w.y = pg8::cvt_pk_bf16(y1[2], y1[3]); w.z = pg8::cvt_pk_bf16(y2[0], y2[1]); w.w = pg8::cvt_pk_bf16(y2[2], y2[3]);
                        *(v4u*)(base + (size_t)row * ldc + 32 * bj + 8 * fq) = w; } }
        }
    }
};
struct EpiF32 {
    static constexpr bool PERM = false, AFTER_DRAIN = false;
    float* O; int ldc;
    __device__ __forceinline__ void operator()(const f32x4 (&acc)[2][2][4][2], const pg8::Unit& u, int wr, int wc, int fr, int fq) const {
        const int row0 = u.pm * 256 + wr * 64 + fr, col0 = u.pn * 256 + wc * 32 + 4 * fq;
#pragma unroll
        for (int ai = 0; ai < 2; ++ai)
#pragma unroll
            for (int m = 0; m < 4; ++m) { float* rowp = O + (size_t)(row0 + ai * 128 + m * 16) * ldc + col0;
#pragma unroll
                for (int bj = 0; bj < 2; ++bj)
#pragma unroll
                    for (int n = 0; n < 2; ++n) *(f32x4*)(rowp + bj * 128 + n * 16) = acc[ai][bj][m][n]; }
    }
};

constexpr int TC = 32;
__device__ __forceinline__ void rwkv_scan_seq(Frame& F, int unit) {
    const int z = unit >> 7, b = (unit >> 3) & 15, h = unit & 7, tid = F.tid, lane = F.lane;
    LAS float* L = (LAS float*)(F.lds + RING_OFF);
    LAS float* WUP = L;              LAS float* AUP = L + 4096;
    LAS float* RR = L + 8192;        LAS float* KR = RR + 2048;  LAS float* VV = KR + 2048;  LAS float* WD = VV + 2048;  LAS float* AD = WD + 2048;
    LAS float* WW = AD + 2048;       LAS float* KK = WW + 2048;  LAS float* AKK = KK + 2048; LAS float* KT = AKK + 2048;
    LAS float* YO = KT + 2048;       LAS float* BO = YO + 2048;
    for (int i = tid; i < 4096; i += 512) { const int r = i >> 6, c = i & 63; WUP[i] = F.w_up[(size_t)(z * 64 + r) * RW + h * 64 + c]; AUP[i] = F.a_up[(size_t)(z * 64 + r) * RW + h * 64 + c]; }
    float S[8];
#pragma unroll
    for (int j = 0; j < 8; ++j) S[j] = 0.f;
    const int c = tid & 63, sg = tid >> 6;
    const float w0c = F.w0[z * RW + h * 64 + c], a0c = F.a0[z * RW + h * 64 + c], kkc = F.k_k[h * 64 + c], kac = F.k_a[h * 64 + c], rkc = F.r_k[h * 64 + c];
    const int vrow = tid >> 3, ks = tid & 7;
    __syncthreads();
    for (int ch = 0; ch < T / TC; ++ch) {
        for (int i = tid; i < 5 * 2048; i += 512) {
            const int arr = i >> 11, rem = i & 2047, sl = rem >> 6, cc = rem & 63, s = ch * TC + sl, t = z ? (T - 1 - s) : s;
            const size_t row = (size_t)b * T + t;
            const bf16* src; int pitch, tapc;
            if (arr < 3) { src = F.RKV + arr * 512 + h * 64 + cc; pitch = 1536; tapc = arr * 512 + h * 64 + cc; }
            else { src = F.WA + (arr - 3) * 64 + cc; pitch = 128; tapc = 1536 + (arr - 3) * 64 + cc; }
            float val = F.taps[RSW + tapc] * bf2f(src[row * pitch]);
            if (t > 0) val += F.taps[tapc] * bf2f(src[(row - 1) * pitch]);
            if (t < T - 1) val += F.taps[2 * RSW + tapc] * bf2f(src[(row + 1) * pitch]);
            if (arr == 3) val = tanhf(val);
            RR[i] = val;
        }
        __syncthreads();
        {
            float wl[4], al[4];
#pragma unroll
            for (int j = 0; j < 4; ++j) { wl[j] = w0c; al[j] = a0c; }
            for (int r = 0; r < 64; r += 4) {
                float wu[4], au[4];
#pragma unroll
                for (int q = 0; q < 4; ++q) { wu[q] = WUP[(r + q) * 64 + c]; au[q] = AUP[(r + q) * 64 + c]; }
#pragma unroll
                for (int j = 0; j < 4; ++j) { const f32x4 wd = *(const LAS f32x4*)(WD + (4 * sg + j) * 64 + r), ad = *(const LAS f32x4*)(AD + (4 * sg + j) * 64 + r);
                    wl[j] += wd[0] * wu[0] + wd[1] * wu[1] + wd[2] * wu[2] + wd[3] * wu[3]; al[j] += ad[0] * au[0] + ad[1] * au[1] + ad[2] * au[2] + ad[3] * au[3]; }
            }
#pragma unroll
            for (int j = 0; j < 4; ++j) { const int sl = 4 * sg + j;
                const float w = __expf(-DECAY_SCALE * sigmoidf_(wl[j])), a = sigmoidf_(al[j]);
                const float kraw = KR[sl * 64 + c], kkv = kraw * kkc;
                const float ssq = wave_sum(kkv * kkv), kkn = kkv / sqrtf(ssq + L2_EPS);
                const float kt = kraw * (1.0f + (a - 1.0f) * kac);
                const float bon = wave_sum(RR[sl * 64 + c] * kt * rkc);
                WW[sl * 64 + c] = w; KK[sl * 64 + c] = kkn; AKK[sl * 64 + c] = a * kkn; KT[sl * 64 + c] = kt;
                if (lane == 0) BO[sl] = bon; }
        }
        __syncthreads();
        for (int sl = 0; sl < TC; ++sl) {
            const LAS float* pw = WW + sl * 64 + ks * 8; const LAS float* pk = KK + sl * 64 + ks * 8; const LAS float* pa = AKK + sl * 64 + ks * 8;
            const LAS float* pt = KT + sl * 64 + ks * 8; const LAS float* pr = RR + sl * 64 + ks * 8;
            const f32x4 w0v = *(const LAS f32x4*)pw, w1v = *(const LAS f32x4*)(pw + 4), k0v = *(const LAS f32x4*)pk, k1v = *(const LAS f32x4*)(pk + 4);
            const f32x4 a0v = *(const LAS f32x4*)pa, a1v = *(const LAS f32x4*)(pa + 4), t0v = *(const LAS f32x4*)pt, t1v = *(const LAS f32x4*)(pt + 4);
            const f32x4 r0v = *(const LAS f32x4*)pr, r1v = *(const LAS f32x4*)(pr + 4);
            const float vv = VV[sl * 64 + vrow];
            float sa = (S[0] * k0v[0] + S[1] * k0v[1]) + (S[2] * k0v[2] + S[3] * k0v[3]) + (S[4] * k1v[0] + S[5] * k1v[1]) + (S[6] * k1v[2] + S[7] * k1v[3]);
            sa += __shfl_xor(sa, 1); sa += __shfl_xor(sa, 2); sa += __shfl_xor(sa, 4);
#pragma unroll
            for (int j = 0; j < 4; ++j) { S[j] = S[j] * w0v[j] - sa * a0v[j] + vv * t0v[j]; S[4 + j] = S[4 + j] * w1v[j] - sa * a1v[j] + vv * t1v[j]; }
            float y = (S[0] * r0v[0] + S[1] * r0v[1]) + (S[2] * r0v[2] + S[3] * r0v[3]) + (S[4] * r1v[0] + S[5] * r1v[1]) + (S[6] * r1v[2] + S[7] * r1v[3]);
            y += __shfl_xor(y, 1); y += __shfl_xor(y, 2); y += __shfl_xor(y, 4);
            if (ks == 0) YO[sl * 64 + vrow] = y;
        }
        __syncthreads();
        for (int i = tid; i < 2048; i += 512) { const int sl = i >> 6, vc = i & 63, s = ch * TC + sl, t = z ? (T - 1 - s) : s;
            F.Y[((size_t)z * M + (size_t)b * T + t) * RW + h * 64 + vc] = YO[i]; }
        if (tid < TC) { const int s = ch * TC + tid, t = z ? (T - 1 - s) : s; F.BON[((size_t)z * M + (size_t)b * T + t) * 8 + h] = BO[tid]; }
    }
}
__device__ __forceinline__ void mix_prep(Frame& F) {
    const int gw = F.vcu * NWAVES + F.wave, NGW = F.G * NWAVES, lane = F.lane;
    for (int m = gw; m < M; m += NGW) {
        const int t = m & (T - 1);
#pragma unroll 2
        for (int h = 0; h < 8; ++h) {
            const int col = h * 64 + lane;
            const float y = F.Y[(size_t)m * RW + col] + F.Y[((size_t)M + m) * RW + col];
            const float mu = wave_sum(y) * (1.0f / 64.0f), dlt = y - mu, var = wave_sum(dlt * dlt) * (1.0f / 64.0f);
            const float yn = dlt / sqrtf(var + GN_EPS) * F.gn_w[col] + F.gn_b[col];
            const float bon = F.BON[(size_t)m * 8 + h] + F.BON[((size_t)M + m) * 8 + h];
            const int tapc = 1024 + col; const bf16* vsrc = F.RKV + 1024 + col;
            float vs = F.taps[RSW + tapc] * bf2f(vsrc[(size_t)m * 1536]);
            if (t > 0) vs += F.taps[tapc] * bf2f(vsrc[(size_t)(m - 1) * 1536]);
            if (t < T - 1) vs += F.taps[2 * RSW + tapc] * bf2f(vsrc[(size_t)(m + 1) * 1536]);
            const float o = (yn + bon * vs) * bf2f(F.GRW[(size_t)m * 512 + col]);
            F.MIX[(size_t)m * D + 512 + col] = (bf16)f2bf(o);
        }
    }
}
__device__ __forceinline__ void final_norm(Frame& F) {
    const int gw = F.vcu * NWAVES + F.wave, NGW = F.G * NWAVES;
    for (int m = gw; m < M; m += NGW) {
        const int b = m / T;
        const GAS f32x4* orow = (const GAS f32x4*)(F.OUTPRE + (size_t)m * D) + F.lane; const GAS f32x4* xr = (const GAS f32x4*)(F.x + (size_t)m * D) + F.lane;
        f32x4 v[4]; float s = 0.f;
#pragma unroll
        for (int j = 0; j < 4; ++j) { v[j] = orow[64 * j]; s += (v[j].x * v[j].x + v[j].y * v[j].y) + (v[j].z * v[j].z + v[j].w * v[j].w); }
        const float rstd = 1.f / sqrtf(wave_sum(s) * (1.f / D) + NORM_EPS);
        GAS f32x4* o = (GAS f32x4*)(F.out + (size_t)m * D) + F.lane;
#pragma unroll
        for (int j = 0; j < 4; ++j) { const int d0 = 256 * j + 4 * F.lane; const f32x4 gp = *(const GAS f32x4*)(F.g_post + d0), gt = *(const GAS f32x4*)(F.MOD + b * 3 * D + 2 * D + d0);
            o[64 * j] = xr[64 * j] + gt * (v[j] * rstd * gp); }
    }
}

struct Args { const float* in[20]; float* out; unsigned char* ws; int ph_lo, ph_hi, li, pad; };
__global__ void __launch_bounds__(NWAVES * 64, 2) hyb_fwd(Args args) {
    extern __shared__ __attribute__((aligned(16))) unsigned char lds[];
    Frame F;
    F.lds = (LAS unsigned char*)lds;
    F.MISC = (volatile LAS unsigned*)(F.lds + MISC_OFF);
    F.tid = threadIdx.x; F.lane = F.tid & 63; F.wave = __builtin_amdgcn_readfirstlane(F.tid >> 6);
    F.G = gridDim.x; { const int bx = blockIdx.x; F.vcu = (F.G % 8 == 0) ? (bx % 8) * (F.G / 8) + bx / 8 : bx; }
#define GRID_BAR(seam) do { if (N_LAUNCHES == PER_PHASE) { if (F.tid == 0) __hip_atomic_store(F.ctl + CW_TMO, 0xBADBA0u | (unsigned)(seam), RLX_AGENT); } \
    else { xcd_barrier(bar); } } while (0)
    unsigned char* ws = args.ws;
    F.ctl = (gu32*)(ws + WS_CTL);
    F.x = args.in[0]; F.c = args.in[1]; F.w_ada = args.in[2]; F.b_ada = args.in[3]; F.g_pre = args.in[4]; F.w_in = args.in[5]; F.q_norm_g = args.in[6]; F.k_norm_g = args.in[7];
    F.taps = args.in[8]; F.w_up = args.in[9]; F.w0 = args.in[10]; F.a_up = args.in[11]; F.a0 = args.in[12]; F.k_k = args.in[13]; F.k_a = args.in[14]; F.r_k = args.in[15];
    F.gn_w = args.in[16]; F.gn_b = args.in[17]; F.w_out = args.in[18]; F.g_post = args.in[19]; F.out = args.out;
    F.MOD = (float*)(ws + WS_MOD); F.ROPE = (float*)(ws + WS_ROPE); F.BON = (float*)(ws + WS_BON); F.Y = (float*)(ws + WS_Y); F.OUTPRE = (float*)(ws + WS_OUTPRE);
    F.Win_t = (bf16*)(ws + WS_WIN); F.Wout_t = (bf16*)(ws + WS_WOUT); F.XN = (bf16*)(ws + WS_XN); F.MIX = (bf16*)(ws + WS_XN);
    F.QB = (bf16*)(ws + WS_Q); F.KB = (bf16*)(ws + WS_K); F.VB = (bf16*)(ws + WS_V); F.GATT = (bf16*)(ws + WS_GATT); F.RKV = (bf16*)(ws + WS_RKV); F.WA = (bf16*)(ws + WS_WA); F.GRW = (bf16*)(ws + WS_GRW);
    for (int u = F.tid; u < (LDS_BYTES - LDSCTL_OFF) / 4; u += NWAVES * 64) ((LAS unsigned*)(F.lds + LDSCTL_OFF))[u] = 0u;
    __syncthreads();
    XcdBarrier bar; bar.bar = (unsigned*)(F.ctl + CW_BAR); bar.x = 0; bar.st = nullptr;
    if (N_LAUNCHES != PER_PHASE) bar = xcd_barrier_post((unsigned*)(F.ctl + CW_BAR), F.MISC + 8);

    const int lo = args.ph_lo, hi = args.ph_hi;
#define IN(k) (lo <= (k) && (k) < hi)
#define BOTH(k) (IN(k) && IN((k) + 1))
    if (IN(0)) { p0_prologue(F); if (BOTH(0)) GRID_BAR(0); }
    if (IN(1)) { p1_xn(F); if (BOTH(1)) GRID_BAR(1); }
    if (IN(2)) {
        pg8::Gemm g{F.XN, F.Win_t, M, NINP, D}; pg8::StaticOrder S; S.init(M, NINP, F.G, (int)blockIdx.x);
        EpiInProj E{F.QB, F.KB, F.VB, F.GATT, F.RKV, F.WA, F.GRW, F.q_norm_g, F.k_norm_g, F.ROPE, attn_body::C2};
        pg8::gemm_phase<EpiInProj, pg8::StaticOrder, PG8_ALIGN, PG8_SP2>(F.lds + RING_OFF, g, S, E);
        if (BOTH(2)) GRID_BAR(2);
    }
    if (IN(3)) {
        const attn_body::AttnTensors AT{(const attn_body::bf16*)F.QB, (const attn_body::bf16*)F.KB, (const attn_body::bf16*)F.VB, (const attn_body::bf16*)F.GATT, (attn_body::bf16*)F.MIX};
        const attn_body::StaticOrder S((int)F.G, (int)blockIdx.x);
        attn_body::attn_phase<attn_body::StaticOrder>((char*)lds + RING_OFF, AT, S);
        __syncthreads();
        for (int u = F.vcu; u < 256; u += F.G) { rwkv_scan_seq(F, u); __syncthreads(); }
        if (BOTH(3)) GRID_BAR(3);
    }
    if (IN(4)) { mix_prep(F); if (BOTH(4)) GRID_BAR(4); }
    if (IN(5)) {
        pg8::Gemm g{F.MIX, F.Wout_t, M, D, D}; pg8::StaticOrder S; S.init(M, D, F.G, (int)blockIdx.x);
        EpiF32 E{F.OUTPRE, D};
        pg8::gemm_phase<EpiF32, pg8::StaticOrder, PG8_ALIGN, PG8_SP2>(F.lds + RING_OFF, g, S, E);
        if (BOTH(5)) GRID_BAR(5);
    }
    if (IN(6)) { final_norm(F); }
#undef IN
#undef BOTH
}

extern "C" void kernel_launch(void* const* d_in, const int* in_sizes, int n_in, void* d_out, int out_size, void* d_ws, size_t ws_size, hipStream_t stream) {
    static int grid = 0;
    if (grid == 0) {
        if (n_in != 20 || in_sizes[0] != M * D || out_size != M * D || ws_size < WS_END) { fprintf(stderr, "kernel_launch: unexpected shapes (n_in %d, in0 %d, out %d, ws %zu); nothing launched\n", n_in, n_in > 0 ? in_sizes[0] : -1, out_size, ws_size); grid = -1; return; }
        int dev = 0, cus = 0, per_cu = 0;
        if (hipGetDevice(&dev) != hipSuccess || hipDeviceGetAttribute(&cus, hipDeviceAttributeMultiprocessorCount, dev) != hipSuccess) { grid = -1; return; }
        if (hipFuncSetAttribute((const void*)hyb_fwd, hipFuncAttributeMaxDynamicSharedMemorySize, LDS_BYTES) != hipSuccess) { fprintf(stderr, "kernel_launch: hipFuncSetAttribute failed\n"); grid = -1; return; }
        if (hipOccupancyMaxActiveBlocksPerMultiprocessor(&per_cu, (const void*)hyb_fwd, NWAVES * 64, LDS_BYTES) != hipSuccess || per_cu < 1)
            fprintf(stderr, "kernel_launch: note: occupancy query reports %d workgroups per CU\n", per_cu);
        (void)hipGetLastError();
        grid = cus;
    }
    if (grid < 0) return;
    if (hipMemsetAsync((char*)d_ws + WS_CTL, 0, CTL_ZERO_BYTES, stream) != hipSuccess) { fprintf(stderr, "kernel_launch: hipMemsetAsync failed\n"); return; }
    Args a{};
    for (int i = 0; i < 20; ++i) a.in[i] = (const float*)d_in[i];
    a.out = (float*)d_out; a.ws = (unsigned char*)d_ws;
    for (int li = 0; li < N_LAUNCHES; ++li) {
        a.ph_lo = (N_LAUNCHES == PER_PHASE) ? li : 0; a.ph_hi = (N_LAUNCHES == PER_PHASE) ? li + 1 : PER_PHASE; a.li = li;
        hipLaunchKernelGGL(hyb_fwd, dim3(grid), dim3(NWAVES * 64), LDS_BYTES, stream, a);
        const hipError_t le = hipPeekAtLastError();
        if (le != hipSuccess) { fprintf(stderr, "kernel_launch: launch %d failed: %s\n", li, hipGetErrorName(le)); break; }
    }
}
```

```cpp
#include <hip/hip_runtime.h>
#include <cstdio>
#include <cstdint>
namespace pg8 {
#define PG8_LAS __attribute__((address_space(3)))
typedef unsigned short bf16_t;
typedef short bf16x8 __attribute__((ext_vector_type(8)));
typedef float f32x4 __attribute__((ext_vector_type(4)));
typedef unsigned u32x4 __attribute__((ext_vector_type(4)));
constexpr int BM = 256, BK = 64, HALF = 128, HTB = HALF * BK * 2  , STAGE_BYTES = 8 * HTB, NXCD = 8, WGM = 8;

__host__ __device__ __forceinline__ int lds_byte(int r, int c) { const int st = (r >> 4) * 2 + (c >> 5), rr = r & 15, cc = c & 31, ob = rr * 64 + cc * 2; return st * 1024 + (ob ^ (((ob >> 9) & 1) << 5)); }
__host__ __device__ __forceinline__ void stage_rc(int b, int& R, int& C) { const int st = b / 1024, sb = b % 1024, swz = sb ^ (((sb >> 9) & 1) << 5); R = (st >> 1) * 16 + swz / 64; C = (st & 1) * 32 + (swz % 64) / 2; }
__host__ __device__ __forceinline__ int perm32(int rho) { const int n = rho >> 4, i = rho & 15; return 8 * (i >> 2) + 4 * n + (i & 3); }

struct Unit { int pm, pn; };
struct Gemm { const bf16_t* A; const bf16_t* Bt; int M, N, K; };

struct StaticOrder {
    int nM, nN, nwg, G, c;
    __host__ __device__ void init(int M, int N, int G_, int c_) { nM = M / BM; nN = N / BM; nwg = nM * nN; G = G_; c = c_; }
    __host__ __device__ bool next(int i, Unit& u) const {
        const long L = (long)i * G + c; if (L >= nwg) return false;
        int wgid = (int)L; { const int q = nwg / NXCD, r = nwg % NXCD, xcd = wgid % NXCD, off = wgid / NXCD; wgid = (xcd < r ? xcd * (q + 1) : r * (q + 1) + (xcd - r) * q) + off; }
        const int nig = WGM * nN, gid = wgid / nig, fm = gid * WGM, gsz = (nM - fm) < WGM ? (nM - fm) : WGM;
        u.pm = fm + ((wgid % nig) % gsz); u.pn = (wgid % nig) / gsz; return true;
    }
    __device__ __forceinline__ void a_ready(const Unit&) const {}
    __device__ __forceinline__ void done(const Unit&) const {}
};

__device__ __forceinline__ unsigned cvt_pk_bf16(float lo, float hi) { unsigned r; asm volatile("v_cvt_pk_bf16_f32 %0, %1, %2" : "=v"(r) : "v"(lo), "v"(hi)); return r; }
template <class Epi, class Sched, bool ALIGN_EPI = false, bool SP2 = false>
__device__ __forceinline__ void gemm_phase(PG8_LAS unsigned char* lds, const Gemm g, const Sched& S, const Epi& E) {
    const int tid = threadIdx.x, wid = __builtin_amdgcn_readfirstlane(tid >> 6), lane = tid & 63, wr = wid >> 2, wc = wid & 3, fr = lane & 15, fq = lane >> 4;
    const int K = g.K, nt = K / BK;
    unsigned voffA[2], voffB[2];
#pragma unroll
    for (int i = 0; i < 2; ++i) { int R, C; stage_rc(tid * 16 + i * 8192, R, C); const int Rb = Epi::PERM ? ((R & ~31) + perm32(R & 31)) : R;
        voffA[i] = (unsigned)(R * K + C) * 2u; voffB[i] = (unsigned)(Rb * K + C) * 2u; }
    const size_t kstep = (size_t)(BK * 2);
    const size_t hstep = (size_t)HALF * K * 2;
    const size_t tstep = 2 * hstep;
    const unsigned ldsw = (unsigned)wid * 1024u;
    const int aoff = lds_byte(wr * 64 + fr, fq * 8), boff = lds_byte(wc * 32 + fr, fq * 8);
#define PG8_SA(b, h) (((b) * 2 + (h)) * HTB)
#define PG8_SB(b, h) ((4 + (b) * 2 + (h)) * HTB)
#define PG8_STAGE(bufoff, gbase, voff) do { _Pragma("unroll") for (int _i = 0; _i < 2; ++_i) \
        __builtin_amdgcn_global_load_lds((const unsigned*)((const char*)(gbase) + (voff)[_i]), (PG8_LAS unsigned*)(lds + (bufoff) + ldsw + _i * 8192), 16, 0, 0); } while (0)
#define PG8_LDA(dst, b, h) do { _Pragma("unroll") for (int m = 0; m < 4; ++m) _Pragma("unroll") for (int k = 0; k < 2; ++k) dst[m][k] = *(const PG8_LAS bf16x8*)(lds + PG8_SA(b, h) + aoff + m * 2048 + k * 1024); } while (0)
#define PG8_LDB(dst, b, h) do { _Pragma("unroll") for (int n = 0; n < 2; ++n) _Pragma("unroll") for (int k = 0; k < 2; ++k) dst[n][k] = *(const PG8_LAS bf16x8*)(lds + PG8_SB(b, h) + boff + n * 2048 + k * 1024); } while (0)
#define PG8_MMA(ai, bj, At, Bt) do { __builtin_amdgcn_s_setprio(1); _Pragma("unroll") for (int m = 0; m < 4; ++m) _Pragma("unroll") for (int n = 0; n < 2; ++n) _Pragma("unroll") for (int k = 0; k < 2; ++k) \
        acc[ai][bj][m][n] = __builtin_amdgcn_mfma_f32_16x16x32_bf16(Bt[n][k], At[m][k], acc[ai][bj][m][n], 0, 0, 0); __builtin_amdgcn_s_setprio(0); } while (0)
#define PG8_WAIT_V(n) asm volatile("s_waitcnt vmcnt(" #n ")" ::: "memory")
#define PG8_WAIT_L(n) asm volatile("s_waitcnt lgkmcnt(" #n ")" ::: "memory")
#define PG8_BAR __builtin_amdgcn_s_barrier()
#define PG8_SCHED __builtin_amdgcn_sched_barrier(0)
    Unit cur, nxt; int ui = 0;
    if (!S.next(0, cur)) return;
    f32x4 acc[2][2][4][2];
#pragma unroll
    for (int a = 0; a < 2; ++a)
#pragma unroll
        for (int b = 0; b < 2; ++b)
#pragma unroll
            for (int m = 0; m < 4; ++m)
#pragma unroll
                for (int n = 0; n < 2; ++n) acc[a][b][m][n] = (f32x4){0.f, 0.f, 0.f, 0.f};
    bf16x8 At[4][2], B0[2][2], B1[2][2];
    const char* cA = (const char*)g.A + (size_t)cur.pm * tstep; const char* cB = (const char*)g.Bt + (size_t)cur.pn * tstep;
    S.a_ready(cur);
    if constexpr (SP2) {
        PG8_STAGE(PG8_SB(0, 0), cB, voffB); PG8_STAGE(PG8_SB(0, 1), cB + hstep, voffB); PG8_STAGE(PG8_SA(0, 0), cA, voffA); PG8_STAGE(PG8_SA(0, 1), cA + hstep, voffA);
        if (wr == 1) PG8_BAR;
        PG8_WAIT_V(2); PG8_BAR;
        PG8_STAGE(PG8_SB(1, 0), cB + kstep, voffB); PG8_STAGE(PG8_SA(1, 0), cA + kstep, voffA); PG8_STAGE(PG8_SB(1, 1), cB + hstep + kstep, voffB);
        PG8_WAIT_V(6); PG8_BAR;
    } else {
        PG8_STAGE(PG8_SB(0, 0), cB, voffB); PG8_STAGE(PG8_SA(0, 0), cA, voffA); PG8_STAGE(PG8_SB(0, 1), cB + hstep, voffB); PG8_STAGE(PG8_SA(0, 1), cA + hstep, voffA);
        if (wr == 1) PG8_BAR;
        PG8_WAIT_V(4); PG8_BAR;
        PG8_STAGE(PG8_SB(1, 0), cB + kstep, voffB); PG8_STAGE(PG8_SA(1, 0), cA + kstep, voffA); PG8_STAGE(PG8_SB(1, 1), cB + hstep + kstep, voffB);
        PG8_WAIT_V(6); PG8_BAR;
    }
    for (;;) {
        const bool has_next = S.next(ui + 1, nxt);
        const char* nA = has_next ? (const char*)g.A + (size_t)nxt.pm * tstep : cA; const char* nB = has_next ? (const char*)g.Bt + (size_t)nxt.pn * tstep : cB;
        for (int t = 0; t < nt; t += 2) {
            const bool last = (t == nt - 2);
            const char* a1 = cA + (size_t)(t + 1) * kstep;
            const char* a2 = last ? nA : cA + (size_t)(t + 2) * kstep; const char* b2 = last ? nB : cB + (size_t)(t + 2) * kstep;
            const char* a3 = a2 + kstep; const char* b3 = b2 + kstep;
            if (last && has_next) S.a_ready(nxt);
            if constexpr (SP2) {
            PG8_LDB(B0, 0, 0); PG8_LDB(B1, 0, 1); PG8_SCHED; PG8_LDA(At, 0, 0); PG8_STAGE(PG8_SA(1, 1), a1 + hstep, voffA);
            PG8_WAIT_V(8); PG8_WAIT_L(0); PG8_BAR; PG8_MMA(0, 0, At, B0); PG8_MMA(0, 1, At, B1); PG8_BAR; PG8_SCHED;
            PG8_LDA(At, 0, 1); PG8_STAGE(PG8_SB(0, 0), b2, voffB); PG8_STAGE(PG8_SB(0, 1), b2 + hstep, voffB); PG8_STAGE(PG8_SA(0, 0), a2, voffA);
            PG8_WAIT_V(8); PG8_WAIT_L(0); PG8_BAR; PG8_MMA(1, 0, At, B0); PG8_MMA(1, 1, At, B1); PG8_BAR; PG8_SCHED;
            PG8_LDB(B0, 1, 0); PG8_LDB(B1, 1, 1); PG8_SCHED; PG8_LDA(At, 1, 0); PG8_STAGE(PG8_SA(0, 1), a2 + hstep, voffA);
            PG8_WAIT_V(8); PG8_WAIT_L(0); PG8_BAR; PG8_MMA(0, 0, At, B0); PG8_MMA(0, 1, At, B1); PG8_BAR; PG8_SCHED;
            PG8_LDA(At, 1, 1); PG8_STAGE(PG8_SB(1, 0), b3, voffB); PG8_STAGE(PG8_SB(1, 1), b3 + hstep, voffB); PG8_STAGE(PG8_SA(1, 0), a3, voffA);
            PG8_WAIT_V(8); PG8_WAIT_L(0); PG8_BAR; PG8_MMA(1, 0, At, B0); PG8_MMA(1, 1, At, B1); PG8_BAR; PG8_SCHED;
            } else {
            PG8_LDB(B0, 0, 0); PG8_SCHED; PG8_LDA(At, 0, 0); PG8_STAGE(PG8_SA(1, 1), a1 + hstep, voffA);
            PG8_WAIT_L(8); PG8_BAR; PG8_WAIT_L(0); PG8_MMA(0, 0, At, B0); PG8_BAR; PG8_SCHED;
            PG8_LDB(B1, 0, 1); PG8_STAGE(PG8_SB(0, 0), b2, voffB);
            PG8_BAR; PG8_WAIT_L(0); PG8_MMA(0, 1, At, B1); PG8_BAR;
            PG8_LDA(At, 0, 1); PG8_STAGE(PG8_SA(0, 0), a2, voffA);
            PG8_BAR; PG8_WAIT_L(0); PG8_MMA(1, 0, At, B0); PG8_BAR; PG8_SCHED;
            PG8_STAGE(PG8_SB(0, 1), b2 + hstep, voffB);
            PG8_WAIT_V(6); PG8_BAR; PG8_MMA(1, 1, At, B1); PG8_BAR;
            PG8_LDB(B0, 1, 0); PG8_SCHED; PG8_LDA(At, 1, 0); PG8_STAGE(PG8_SA(0, 1), a2 + hstep, voffA);
            PG8_WAIT_L(8); PG8_BAR; PG8_WAIT_L(0); PG8_MMA(0, 0, At, B0); PG8_BAR; PG8_SCHED;
            PG8_LDB(B1, 1, 1); PG8_STAGE(PG8_SB(1, 0), b3, voffB);
            PG8_BAR; PG8_WAIT_L(0); PG8_MMA(0, 1, At, B1); PG8_BAR;
            PG8_LDA(At, 1, 1); PG8_STAGE(PG8_SA(1, 0), a3, voffA);
            PG8_BAR; PG8_WAIT_L(0); PG8_MMA(1, 0, At, B0); PG8_BAR; PG8_SCHED;
            PG8_STAGE(PG8_SB(1, 1), b3 + hstep, voffB);
            PG8_WAIT_V(6); PG8_BAR; PG8_MMA(1, 1, At, B1); PG8_BAR;
            }
        }
        if constexpr (ALIGN_EPI) { if (wr == 0) PG8_BAR; }
        if constexpr (!Epi::AFTER_DRAIN) { E(acc, cur, wr, wc, fr, fq); S.done(cur); }
        if (!has_next) break;
#pragma unroll
        for (int a = 0; a < 2; ++a)
#pragma unroll
            for (int b = 0; b < 2; ++b)
#pragma unroll
                for (int m = 0; m < 4; ++m)
#pragma unroll
                    for (int n = 0; n < 2; ++n) acc[a][b][m][n] = (f32x4){0.f, 0.f, 0.f, 0.f};
        cur = nxt; cA = nA; cB = nB; ++ui;
        if constexpr (ALIGN_EPI) { if (wr == 1) PG8_BAR; }
    }
    PG8_WAIT_V(0);
    if constexpr (!ALIGN_EPI) { if (wr == 0) PG8_BAR; }
    PG8_BAR;
    if constexpr (Epi::AFTER_DRAIN) { E.fused(acc, cur, wr, wc, fr, fq, lds, wid, lane); S.done(cur); }
#undef PG8_SA
#undef PG8_SB
#undef PG8_STAGE
#undef PG8_LDA
#undef PG8_LDB
#undef PG8_MMA
#undef PG8_WAIT_V
#undef PG8_WAIT_L
#undef PG8_BAR
#undef PG8_SCHED
}
}
#ifndef PG8_SP2
#define PG8_SP2 true
#endif
#ifndef PG8_ALIGN
#define PG8_ALIGN true
#endif
#include <hip/hip_bf16.h>
#include <cmath>
namespace attn_body {
using bf16=__hip_bfloat16;
using bf16x8=__attribute__((ext_vector_type(8)))short;
using s16x4=__attribute__((ext_vector_type(4)))short;
using f32x16=__attribute__((ext_vector_type(16)))float;
using u32x4=__attribute__((ext_vector_type(4)))unsigned;
constexpr int BATCH=16,NHEAD=8,GQA=4,SEQ=2048,D=64;
constexpr int QP=512,KP=128,GP=512,OP=1024;
constexpr int NW=8,QBLK=32,QB=QBLK*NW,KVBLK=64,NQB=SEQ/QB;
__device__ __forceinline__ int crow(int r,int hi){return (r&3)+8*(r>>2)+4*hi;}
#define SBAR() __builtin_amdgcn_sched_barrier(0)
constexpr int NSLOT=3, SLOTB=8192;
constexpr int LDS_K=0, LDS_V=NSLOT*SLOTB, LDS_WS=2*NSLOT*SLOTB, LDS_OST=LDS_WS+NW*64*4, LDS_BYTES=LDS_OST+NW*4096;
constexpr float C2=0.125f*1.4426950408889634f;
__device__ __forceinline__ void glds16(const void*gsrc,unsigned lds_dst){unsigned keep;
  asm volatile("s_mov_b32 %0, m0\n\ts_mov_b32 m0, %2\n\ts_nop 0\n\tglobal_load_lds_dwordx4 %1, off\n\ts_mov_b32 m0, %0":"=&s"(keep):"v"(gsrc),"s"(lds_dst):"memory");}
__device__ __forceinline__ float max3f(float a,float b,float c){float r;asm("v_max3_f32 %0, %1, %2, %3":"=v"(r):"v"(a),"v"(b),"v"(c));return r;}
__device__ __forceinline__ float max2f(float a,float b){float r;asm("v_max_f32_e32 %0, %1, %2":"=v"(r):"v"(a),"v"(b));return r;}
__device__ __forceinline__ float fadd_s(float a,float b){float r;asm("v_add_f32_e32 %0, %1, %2":"=v"(r):"v"(a),"v"(b));return r;}
__device__ __forceinline__ float fsub_s(float a,float b){float r;asm("v_sub_f32_e32 %0, %1, %2":"=v"(r):"v"(a),"v"(b));return r;}
typedef float f32x2_t __attribute__((ext_vector_type(2))); typedef __bf16 bf16x2_t __attribute__((ext_vector_type(2)));
__device__ __forceinline__ unsigned cvtpk_s(float lo,float hi){f32x2_t v={lo,hi};bf16x2_t b=__builtin_convertvector(v,bf16x2_t);return __builtin_bit_cast(unsigned,b);}
#define WAIT_BAR(N) asm volatile("s_waitcnt vmcnt(" #N ") lgkmcnt(0)\n\ts_barrier":::"memory")

__device__ __forceinline__ void qkt(f32x16&p0,f32x16&p1,const char*Kslot,const bf16x8*qr,const f32x16&negm,int r32,int hi){
  const char*kb=Kslot+hi*1024+r32*16;
  #pragma unroll
  for(int d0=0;d0<4;++d0){
    const bf16x8 b0=*reinterpret_cast<const bf16x8*>(kb+d0*2048);
    const bf16x8 b1=*reinterpret_cast<const bf16x8*>(kb+d0*2048+512);
    if(d0==0){p0=__builtin_amdgcn_mfma_f32_32x32x16_bf16(b0,qr[0],negm,0,0,0);p1=__builtin_amdgcn_mfma_f32_32x32x16_bf16(b1,qr[0],negm,0,0,0);}
    else{p0=__builtin_amdgcn_mfma_f32_32x32x16_bf16(b0,qr[d0],p0,0,0,0);p1=__builtin_amdgcn_mfma_f32_32x32x16_bf16(b1,qr[d0],p1,0,0,0);}}
}
typedef __attribute__((address_space(3))) const char* lds_cptr;
typedef short v4i16_t __attribute__((ext_vector_type(4)));
__device__ __forceinline__ void kload8(bf16x8*kf,lds_cptr kp){
  kf[0]=*(const __attribute__((address_space(3))) bf16x8*)(kp);      kf[1]=*(const __attribute__((address_space(3))) bf16x8*)(kp+512);
  kf[2]=*(const __attribute__((address_space(3))) bf16x8*)(kp+2048); kf[3]=*(const __attribute__((address_space(3))) bf16x8*)(kp+2560);
  kf[4]=*(const __attribute__((address_space(3))) bf16x8*)(kp+4096); kf[5]=*(const __attribute__((address_space(3))) bf16x8*)(kp+4608);
  kf[6]=*(const __attribute__((address_space(3))) bf16x8*)(kp+6144); kf[7]=*(const __attribute__((address_space(3))) bf16x8*)(kp+6656);
}
__device__ __forceinline__ void kload2(bf16x8*kf,lds_cptr kp,int j){ kf[2*j]=*(const __attribute__((address_space(3))) bf16x8*)(kp+j*2048); kf[2*j+1]=*(const __attribute__((address_space(3))) bf16x8*)(kp+j*2048+512); }
__device__ __forceinline__ s16x4 vtr(lds_cptr p){ return __builtin_bit_cast(s16x4,__builtin_amdgcn_ds_read_tr16_b64_v4i16((__attribute__((address_space(3))) v4i16_t*)p)); }
__device__ __forceinline__ float rowmax(const f32x16&p0,const f32x16&p1){
  float a=max3f(p0[0],p0[1],p1[0]),b=max3f(p0[2],p0[3],p1[1]);a=max3f(a,p1[2],p1[3]);
  #pragma unroll
  for(int r=4;r<16;r+=4){a=max3f(a,p0[r],p0[r+1]);b=max3f(b,p0[r+2],p0[r+3]);a=max3f(a,p1[r],p1[r+1]);b=max3f(b,p1[r+2],p1[r+3]);}
  const float m=max2f(a,b);
  auto rr=__builtin_amdgcn_permlane32_swap(__float_as_uint(m),__float_as_uint(m),false,false);
  return max2f(__uint_as_float(rr[0]),__uint_as_float(rr[1]));
}
__device__ __forceinline__ void pv(f32x16*o,int vb,bf16x8 pa0,bf16x8 pa1,bf16x8 pa2,bf16x8 pa3){
  #pragma unroll
  for(int d0=0;d0<2;++d0){s16x4 lo[4],hi[4];
    #pragma unroll
    for(int ks=0;ks<4;++ks){
      asm volatile("ds_read_b64_tr_b16 %0,%1 offset:%c2":"=&v"(lo[ks]):"v"(vb),"i"(d0*4096+ks*1024):"memory");
      asm volatile("ds_read_b64_tr_b16 %0,%1 offset:%c2":"=&v"(hi[ks]):"v"(vb),"i"(d0*4096+ks*1024+512):"memory");}
    asm volatile("s_waitcnt lgkmcnt(0)":::"memory");SBAR();
    #define PK(k) (bf16x8){lo[k][0],lo[k][1],lo[k][2],lo[k][3],hi[k][0],hi[k][1],hi[k][2],hi[k][3]}
    o[d0]=__builtin_amdgcn_mfma_f32_32x32x16_bf16(pa0,PK(0),o[d0],0,0,0);
    o[d0]=__builtin_amdgcn_mfma_f32_32x32x16_bf16(pa1,PK(1),o[d0],0,0,0);
    o[d0]=__builtin_amdgcn_mfma_f32_32x32x16_bf16(pa2,PK(2),o[d0],0,0,0);
    o[d0]=__builtin_amdgcn_mfma_f32_32x32x16_bf16(pa3,PK(3),o[d0],0,0,0);
    #undef PK
  }
}
#ifndef ATTN_STORE16
#define ATTN_STORE16(p,v) (*(u32x4*)(p)=(v))
#endif
template<int THRL> __device__ __forceinline__ void attn_unit(int b,int h,int qb,const bf16*Q,const bf16*__restrict__ K,const bf16*__restrict__ V,const bf16*__restrict__ G,bf16*O,char*shm){
  const int tid=threadIdx.x,lane=tid&63,r32=lane&31,hi=lane>>5; const int wid=__builtin_amdgcn_readfirstlane(tid>>6);
  const long rowbase=(long)b*SEQ; const int q0=qb*QB;
  const bf16*Qw=Q+(rowbase+q0+wid*QBLK)*QP+h*D; const int kvh=h/GQA;
  const bf16*Kh=K+rowbase*KP+kvh*D,*Vh=V+rowbase*KP+kvh*D;
  const unsigned lds0=(unsigned)(uintptr_t)shm;
  float*wsf=(float*)(shm+LDS_WS)+wid*64;
  const bf16*ksrc=Kh+(long)lane*KP+wid*8;
  const bf16*vsrc=Vh+(long)(16*(wid&3)+(lane>>2))*KP+(wid>>2)*32+(lane&3)*8;
  const unsigned kdst=lds0+LDS_K+wid*1024, vdst=lds0+LDS_V+wid*1024;
  #define DMA_K(t,slot) glds16(ksrc+(long)(t)*KVBLK*KP,(unsigned)__builtin_amdgcn_readfirstlane(kdst+(slot)))
  #define DMA_V(t,slot) glds16(vsrc+(long)(t)*KVBLK*KP,(unsigned)__builtin_amdgcn_readfirstlane(vdst+(slot)))
  const int vb0=(int)(lds0+LDS_V)+((lane>>4)&1)*32+(lane&3)*8+(4*hi+((lane&15)>>2))*64;
  const char*Kbase=shm+LDS_K; bf16x8 kf[8];
  const lds_cptr shm3=(lds_cptr)shm; const lds_cptr kp0=shm3+LDS_K+hi*1024+r32*16; const lds_cptr vp0=shm3+LDS_V+((lane>>4)&1)*32+(lane&3)*8+(4*hi+((lane&15)>>2))*64;
  constexpr int NT=SEQ/KVBLK;
  DMA_K(0,0);DMA_V(0,0);DMA_K(1,SLOTB);
  bf16x8 qr[4];
  #pragma unroll
  for(int d0=0;d0<4;++d0)qr[d0]=*reinterpret_cast<const bf16x8*>(&Qw[(long)r32*QP+d0*16+hi*8]);
  float mhat=0.f,l_reg=0.f;f32x16 o[2];o[0]=f32x16{};o[1]=f32x16{};f32x16 negm=f32x16{};asm volatile("":"+v"(negm));
  #define CMASK(P0,P1,t) do{}while(0)
  bool resc=false;
  #define START(P0,P1) do{ const float rm=rowmax(P0,P1); resc=false; \
    { const float dl=rm; mhat=fadd_s(mhat,dl); \
      _Pragma("unroll") for(int r=0;r<16;++r){P0[r]=fsub_s(P0[r],dl);P1[r]=fsub_s(P1[r],dl);} \
      _Pragma("unroll") for(int r=0;r<16;++r)negm[r]=-mhat; asm volatile("":"+v"(negm)); } \
    _Pragma("unroll") for(int r=0;r<16;++r)P0[r]=__builtin_amdgcn_exp2f(P0[r]); }while(0)
  #define RESC() do{ if(resc){ asm volatile("s_waitcnt lgkmcnt(0)":::"memory"); \
      _Pragma("unroll") for(int d_=0;d_<2;++d_) _Pragma("unroll") for(int r=0;r<16;++r)o[d_][r]*=wsf[crow(r,hi)]; } }while(0)
  f32x16 pA0,pA1,pB0,pB1;
  int sl_prev=0,sl_cur=0,sl_next=SLOTB;
  #define ROT() do{sl_prev=sl_cur;sl_cur=sl_next;sl_next=(sl_next==(NSLOT-1)*SLOTB)?0:sl_next+SLOTB;}while(0)
  DMA_K(2,2*SLOTB);
  WAIT_BAR(3);
  qkt(pA0,pA1,Kbase,qr,negm,r32,hi);asm volatile("s_nop 15\n\ts_nop 7":"+v"(pA0),"+v"(pA1));CMASK(pA0,pA1,0);
  START(pA0,pA1);
  _Pragma("unroll") for(int r=0;r<16;++r)pA1[r]=__builtin_amdgcn_exp2f(pA1[r]);
  WAIT_BAR(0);
  DMA_K(3,0);DMA_V(1,SLOTB);
  ROT();
  kload8(kf,kp0+sl_cur);
  WAIT_BAR(2);
  s16x4 vlo[8],vhi[8]; u32x4 pw0,pw1,pw2,pw3;
  #define PKW(P,B) cvtpk_s(P[B],P[B+1])
  #define PAF(k) __builtin_bit_cast(bf16x8,pw##k)
  #define VFR(i) (bf16x8){vlo[i][0],vlo[i][1],vlo[i][2],vlo[i][3],vhi[i][0],vhi[i][1],vhi[i][2],vhi[i][3]}
  #define PIN(x) asm volatile("":"+v"(x))
  #define MX3(a,b,c) __builtin_fmaxf(__builtin_fmaxf((a),(b)),(c))
  #define GAPA(MF,A0,A1,A2,A3,W0,W1,PW) do{ MF; sacc+=A0; sacc+=A1; sacc+=A2; sacc+=A3; PIN(sacc); W0; W1; PIN(PW); SBAR(); }while(0)
  #define EX(v) __builtin_amdgcn_exp2f(v)
  #define GAPB(MF,X,B) do{ MF; X[B]=EX(X[B]); X[B+1]=EX(X[B+1]); X[B+2]=EX(X[B+2]); X[B+3]=EX(X[B+3]); PIN(X); SBAR(); }while(0)
  #define VRD(i) do{ vlo[i]=vtr(vp_+(((i)>>2)*4096+((i)&3)*1024)); vhi[i]=vtr(vp_+(((i)>>2)*4096+((i)&3)*1024+512)); }while(0)
  #define KRD(G,j) do{ if(G){ kload2(kf,kp0+sl_next,j); SBAR(); } }while(0)
  #define STEP(C0,C1,P0,P1,t,GK,GV,GL) do{ SBAR(); \
    const lds_cptr vp_=vp0+sl_prev; \
    VRD(0); SBAR(); float sacc=(P0[0]+P0[1]); \
    GAPA(C0=__builtin_amdgcn_mfma_f32_32x32x16_bf16(kf[0],qr[0],negm,0,0,0), P0[2],P0[3],P0[4],P0[5],     pw0[0]=PKW(P0,0), pw0[1]=PKW(P0,2), pw0); \
    VRD(4); SBAR(); GAPA(C1=__builtin_amdgcn_mfma_f32_32x32x16_bf16(kf[1],qr[0],negm,0,0,0), P0[6],P0[7],P0[8],P0[9],     pw0[2]=PKW(P0,4), pw0[3]=PKW(P0,6), pw0); \
    VRD(1); SBAR(); GAPA(C0=__builtin_amdgcn_mfma_f32_32x32x16_bf16(kf[2],qr[1],C0,0,0,0),   P0[10],P0[11],P0[12],P0[13], pw1[0]=PKW(P0,8), pw1[1]=PKW(P0,10), pw1); \
    VRD(5); SBAR(); GAPA(C1=__builtin_amdgcn_mfma_f32_32x32x16_bf16(kf[3],qr[1],C1,0,0,0),   P0[14],P0[15],P1[0],P1[1],   pw1[2]=PKW(P0,12),pw1[3]=PKW(P0,14), pw1); \
    VRD(2); SBAR(); GAPA(C0=__builtin_amdgcn_mfma_f32_32x32x16_bf16(kf[4],qr[2],C0,0,0,0),   P1[2],P1[3],P1[4],P1[5],     pw2[0]=PKW(P1,0), pw2[1]=PKW(P1,2), pw2); \
    VRD(6); SBAR(); GAPA(C1=__builtin_amdgcn_mfma_f32_32x32x16_bf16(kf[5],qr[2],C1,0,0,0),   P1[6],P1[7],P1[8],P1[9],     pw2[2]=PKW(P1,4), pw2[3]=PKW(P1,6), pw2); \
    VRD(3); SBAR(); GAPA(C0=__builtin_amdgcn_mfma_f32_32x32x16_bf16(kf[6],qr[3],C0,0,0,0),   P1[10],P1[11],P1[12],P1[13], pw3[0]=PKW(P1,8), pw3[1]=PKW(P1,10), pw3); \
    VRD(7); SBAR(); GAPA(C1=__builtin_amdgcn_mfma_f32_32x32x16_bf16(kf[7],qr[3],C1,0,0,0),   P1[14],P1[15],0.f,0.f,       pw3[2]=PKW(P1,12),pw3[3]=PKW(P1,14), pw3); \
    l_reg+=sacc; \
    if(GK){DMA_K((t)+3,sl_cur);} if(GV){DMA_V((t)+1,sl_next);} \
    CMASK(C0,C1,t); \
    { float a=MX3(C0[0],C0[1],C1[0]),b=MX3(C0[2],C0[3],C1[1]); a=MX3(a,C1[2],C1[3]); \
      _Pragma("unroll") for(int r=4;r<16;r+=4){a=MX3(a,C0[r],C0[r+1]);b=MX3(b,C0[r+2],C0[r+3]);a=MX3(a,C1[r],C1[r+1]);b=MX3(b,C1[r+2],C1[r+3]);} \
      float rm=__builtin_fmaxf(a,b); { auto rr=__builtin_amdgcn_permlane32_swap(__float_as_uint(rm),__float_as_uint(rm),false,false); rm=__builtin_fmaxf(__uint_as_float(rr[0]),__uint_as_float(rr[1])); } \
      resc=false; \
      if(__builtin_expect(__any(rm>(float)THRL),0)){ const float dl=__builtin_fmaxf(rm,0.f); mhat+=dl; \
        _Pragma("unroll") for(int r=0;r<16;++r){C0[r]-=dl;C1[r]-=dl;} \
        _Pragma("unroll") for(int r=0;r<16;++r)negm[r]=-mhat; asm volatile("":"+v"(negm)); \
        const float f=__builtin_amdgcn_exp2f(-dl); l_reg*=f; if(hi==0)wsf[r32]=f; resc=true; } } \
    SBAR(); \
    GAPB(o[0]=__builtin_amdgcn_mfma_f32_32x32x16_bf16(PAF(0),VFR(0),o[0],0,0,0), C0,0); \
    GAPB(o[1]=__builtin_amdgcn_mfma_f32_32x32x16_bf16(PAF(0),VFR(4),o[1],0,0,0), C0,4); \
    KRD(GL,0); GAPB(o[0]=__builtin_amdgcn_mfma_f32_32x32x16_bf16(PAF(1),VFR(1),o[0],0,0,0), C0,8); \
    KRD(GL,1); GAPB(o[1]=__builtin_amdgcn_mfma_f32_32x32x16_bf16(PAF(1),VFR(5),o[1],0,0,0), C0,12); \
    KRD(GL,2); GAPB(o[0]=__builtin_amdgcn_mfma_f32_32x32x16_bf16(PAF(2),VFR(2),o[0],0,0,0), C1,0); \
    KRD(GL,3); GAPB(o[1]=__builtin_amdgcn_mfma_f32_32x32x16_bf16(PAF(2),VFR(6),o[1],0,0,0), C1,4); \
    GAPB(o[0]=__builtin_amdgcn_mfma_f32_32x32x16_bf16(PAF(3),VFR(3),o[0],0,0,0), C1,8); \
    GAPB(o[1]=__builtin_amdgcn_mfma_f32_32x32x16_bf16(PAF(3),VFR(7),o[1],0,0,0), C1,12); \
    }while(0)
  int t=1;
  #undef CMASK
  #define CMASK(P0,P1,t) do{}while(0)
  for(;t+5<NT;t+=2){
    STEP(pB0,pB1,pA0,pA1,t,true,true,true);     WAIT_BAR(2); RESC(); ROT();
    STEP(pA0,pA1,pB0,pB1,t+1,true,true,true);   WAIT_BAR(2); RESC(); ROT();
  }
  #undef CMASK
  #define CMASK(P0,P1,t) do{}while(0)
  #define ENDW(tt) do{ if((tt)+3<NT){WAIT_BAR(2);} else if((tt)+2<NT){WAIT_BAR(1);} else {WAIT_BAR(0);} }while(0)
  for(;t+1<NT;t+=2){
    STEP(pB0,pB1,pA0,pA1,t,(t+3<NT),(t+1<NT),(t+1<NT));       ENDW(t);   RESC(); ROT();
    STEP(pA0,pA1,pB0,pB1,t+1,(t+4<NT),(t+2<NT),(t+2<NT));     ENDW(t+1); RESC(); ROT();
  }
  STEP(pB0,pB1,pA0,pA1,NT-1,false,false,false); RESC();
  { float sacc=pB0[0]+pB0[1]; _Pragma("unroll") for(int r=2;r<16;++r)sacc+=pB0[r]; _Pragma("unroll") for(int r=0;r<16;++r)sacc+=pB1[r]; l_reg+=sacc;
    pw0=(u32x4){PKW(pB0,0),PKW(pB0,2),PKW(pB0,4),PKW(pB0,6)};pw1=(u32x4){PKW(pB0,8),PKW(pB0,10),PKW(pB0,12),PKW(pB0,14)};pw2=(u32x4){PKW(pB1,0),PKW(pB1,2),PKW(pB1,4),PKW(pB1,6)};pw3=(u32x4){PKW(pB1,8),PKW(pB1,10),PKW(pB1,12),PKW(pB1,14)};
    SBAR(); pv(o,vb0+sl_cur,PAF(0),PAF(1),PAF(2),PAF(3)); }
  #undef PKW
  #undef PAF
  #undef VFR
  #undef PIN
  #undef MX3
  #undef GAPA
  #undef GAPB
  #undef EX
  #undef VRD
  #undef KRD
  #undef STEP
  #undef ENDW
  {auto rr=__builtin_amdgcn_permlane32_swap(__float_as_uint(l_reg),__float_as_uint(l_reg),false,false);l_reg=__uint_as_float(rr[0])+__uint_as_float(rr[1]);}
  if(hi==0)wsf[32+r32]=l_reg;asm volatile("s_waitcnt lgkmcnt(0)":::"memory");
  float rli[16];
  #pragma unroll
  for(int r=0;r<16;++r)rli[r]=__builtin_amdgcn_rcpf(wsf[32+crow(r,hi)]);
  bf16*Ow=O+(rowbase+q0+wid*QBLK)*OP+h*D; const bf16*Gw=G+(rowbase+q0+wid*QBLK)*GP+h*D;
  { bf16*stg=(bf16*)(shm+LDS_OST)+wid*2048;
    #pragma unroll
    for(int r=0;r<16;++r){const int orow=crow(r,hi);
      #pragma unroll
      for(int d0=0;d0<2;++d0)stg[orow*64+d0*32+r32]=__float2bfloat16(o[d0][r]*rli[r]);}
    asm volatile("s_waitcnt lgkmcnt(0)":::"memory");
    #pragma unroll
    for(int i=0;i<4;++i){const int row=i*8+(lane>>3),ch=lane&7; const u32x4 v=*(const u32x4*)(stg+row*64+ch*8); const u32x4 g=*(const u32x4*)(Gw+(long)row*GP+ch*8); u32x4 w;
      #pragma unroll
      for(int e=0;e<4;++e){ const float a0=__uint_as_float(v[e]<<16)*__uint_as_float(g[e]<<16), a1=__uint_as_float(v[e]&0xffff0000u)*__uint_as_float(g[e]&0xffff0000u); w[e]=cvtpk_s(a0,a1);}
      ATTN_STORE16(Ow+(long)row*OP+ch*8,w);} }
  asm volatile("s_waitcnt lgkmcnt(0)\n\ts_barrier":::"memory");
  #undef DMA_K
  #undef DMA_V
  #undef CMASK
  #undef START
  #undef RESC
  #undef ROT
}
constexpr int ATTN_LDS_BYTES=LDS_BYTES;
struct AttnTensors { const bf16* Q; const bf16* K; const bf16* V; const bf16* G; bf16* O; };
struct AttnUnit { int bh; int qb; };
struct StaticOrder {
  int vcu, upc;
  __device__ __forceinline__ explicit StaticOrder(int grid,int block):vcu((grid%8==0)?(block%8)*(grid/8)+block/8:block),upc((BATCH*NHEAD*NQB+grid-1)/grid){}
  __device__ __forceinline__ bool next(int i,AttnUnit&u)const{ if(i>=upc)return false; const int x=vcu*upc+i; if(x>=BATCH*NHEAD*NQB)return false; u.qb=x%NQB; u.bh=x/NQB; return true; }
  __device__ __forceinline__ void a_ready(const AttnUnit&)const{}
  __device__ __forceinline__ void done(const AttnUnit&)const{}
};
template<class Sched,int THRL=8> __device__ __forceinline__ void attn_phase(char*lds,const AttnTensors&T,const Sched&S){
  AttnUnit u;
  for(int i=0;S.next(i,u);++i){ S.a_ready(u); attn_unit<THRL>(u.bh/NHEAD,u.bh%NHEAD,u.qb,T.Q,T.K,T.V,T.G,T.O,lds); S.done(u); }
}
#undef SBAR
#undef WAIT_BAR
}
constexpr int NWAVES = 8;
#ifndef MK_N_LAUNCHES
#define MK_N_LAUNCHES 1
#endif
constexpr int PER_PHASE = 7;
constexpr int N_LAUNCHES = MK_N_LAUNCHES;
static_assert(N_LAUNCHES == 1 || N_LAUNCHES == PER_PHASE, "MK_N_LAUNCHES is 1 or 7");

constexpr int BATCH = 16, T = 2048, D = 1024, HD = 64;
constexpr int M = BATCH * T;
constexpr int NIN = 3456, NINP = 3584;
constexpr int RW = 512, RSW = 1664;
constexpr float NORM_EPS = 1e-6f, GN_EPS = 64e-5f, L2_EPS = 1e-12f, DECAY_SCALE = 0.6065306597126334f;

constexpr size_t MiB = 1u << 20;
constexpr size_t WS_CTL = 0, CTL_ZERO_BYTES = 1 * MiB;
constexpr size_t WS_MOD = 512 * 1024;
constexpr size_t WS_ROPE = 1 * MiB;
constexpr size_t WS_WIN = 2 * MiB;
constexpr size_t WS_WOUT = 10 * MiB;
constexpr size_t WS_XCH = 12 * MiB;
constexpr size_t WS_BON = 14 * MiB;
constexpr size_t WS_XN = 16 * MiB;
constexpr size_t WS_Q = 80 * MiB, WS_K = 112 * MiB, WS_V = 120 * MiB;
constexpr size_t WS_GATT = 128 * MiB;
constexpr size_t WS_RKV = 160 * MiB;
constexpr size_t WS_WA = 256 * MiB;
constexpr size_t WS_GRW = 264 * MiB;
constexpr size_t WS_Y = 296 * MiB;
constexpr size_t WS_OUTPRE = 80 * MiB;
constexpr size_t WS_END = 424 * MiB;
constexpr int CW_TMO = 0, CW_CODE = 1;
constexpr int CW_BAR = 4096;
constexpr int CW_SEAM = 16384;

constexpr int RING_OFF = 0, RING_BYTES = 143360;
constexpr int LDSCTL_OFF = RING_BYTES, MISC_OFF = LDSCTL_OFF + 320;
constexpr int LDS_BYTES = 147456;
static_assert(MISC_OFF + 128 <= LDS_BYTES, "LDS map");
#define GAS __attribute__((address_space(1)))
#define LAS __attribute__((address_space(3)))
typedef unsigned short bf16;
typedef unsigned v4u __attribute__((ext_vector_type(4)));
typedef float f32x4 __attribute__((ext_vector_type(4)));
typedef short bf16x8 __attribute__((ext_vector_type(8)));
typedef GAS unsigned gu32;
typedef GAS unsigned long long gu64;
#define RLX_AGENT __ATOMIC_RELAXED, __HIP_MEMORY_SCOPE_AGENT
#define LDS_WAIT() asm volatile("s_waitcnt lgkmcnt(0)" ::: "memory")
#define VM_WAIT() asm volatile("s_waitcnt vmcnt(0)" ::: "memory")
__device__ __forceinline__ unsigned long long rt() { return __builtin_amdgcn_s_memrealtime(); }
__device__ __forceinline__ unsigned f2bf(float f) { unsigned u = __builtin_bit_cast(unsigned, f); return (u + 0x7fffu + ((u >> 16) & 1u)) >> 16; }
__device__ __forceinline__ unsigned pk2(float lo, float hi) { return f2bf(lo) | (f2bf(hi) << 16); }

#define XB_TMO      128
#define XB_XCNT(j)  (256  + 64 * (j))
#define XB_XSUB(j)  (1280 + 64 * (j))
#define XB_XGEN(j)  (2304 + 64 * (j))
#define XB_TOP      3328
#define XB_TOPGEN   3392
#define XCD_BAR_WORDS 3456
#define XB_SPIN_CAP (1u << 18)

__device__ __forceinline__ unsigned xb_ld(unsigned* p)              { return __hip_atomic_load(p, __ATOMIC_RELAXED, __HIP_MEMORY_SCOPE_AGENT); }
__device__ __forceinline__ unsigned xb_add(unsigned* p, unsigned v) { return __hip_atomic_fetch_add(p, v, __ATOMIC_RELAXED, __HIP_MEMORY_SCOPE_AGENT); }
__device__ __forceinline__ unsigned xb_xcc_id() { return (unsigned)__builtin_amdgcn_s_getreg((3 << 11) | 20) & 0xFu; }
#define XB_SPIN(cond, bar) do { unsigned _sp = 0; while (cond) { __builtin_amdgcn_s_sleep(1); \
    if ((++_sp & 255u) == 0u) { if (xb_ld(&(bar)[XB_TMO])) break; if (_sp > XB_SPIN_CAP) { atomicAdd(&(bar)[XB_TMO], 1u); break; } } } } while (0)

struct XcdBarrier {
    unsigned* bar; unsigned x;
    volatile LAS unsigned* st;
};

__device__ __forceinline__ XcdBarrier xcd_barrier_post(unsigned* bar, volatile LAS unsigned* st) {
    XcdBarrier b; b.bar = bar; b.x = xb_xcc_id(); b.st = st;
    if (threadIdx.x == 0) (void)xb_add(&bar[XB_XCNT(b.x)], 1u);
    return b;
}
__device__ __forceinline__ void xcd_barrier_complete(unsigned* bar, unsigned x, unsigned& nloc, unsigned& nx) {
    const unsigned G = gridDim.x * gridDim.y * gridDim.z;
    unsigned sum, cnt, mine, sp = 0u;
    for (;;) {
        sum = 0u; cnt = 0u; mine = 0u;
#pragma unroll
        for (unsigned j = 0; j < 16; ++j) { const unsigned c = xb_ld(&bar[XB_XCNT(j)]); sum += c; cnt += (c > 0u) ? 1u : 0u; mine = (j == x) ? c : mine; }
        if (sum == G) break;
        __builtin_amdgcn_s_sleep(1);
        if ((++sp & 255u) == 0u) { if (xb_ld(&bar[XB_TMO])) break; if (sp > XB_SPIN_CAP) { atomicAdd(&bar[XB_TMO], 1u); break; } }
    }
    nloc = mine > 0u ? mine : 1u; nx = cnt > 0u ? cnt : 1u;
}

__device__ __forceinline__ void xcd_barrier(const XcdBarrier& b) {
    asm volatile("s_waitcnt vmcnt(0)" ::: "memory");
    __syncthreads();
    if (threadIdx.x == 0) {
        unsigned* bar = b.bar;
        __builtin_amdgcn_s_waitcnt(0);
        unsigned nloc = b.st[0], nx = b.st[1];
        if (nloc == 0u) { xcd_barrier_complete(bar, b.x, nloc, nx); b.st[0] = nloc; b.st[1] = nx; }
        const unsigned old = xb_add(&bar[XB_XSUB(b.x)], 1u);
        const unsigned gen = old / nloc;
        if (old + 1u == (gen + 1u) * nloc) {
            __builtin_amdgcn_fence(__ATOMIC_RELEASE, "agent");
            asm volatile("s_waitcnt vmcnt(0)" ::: "memory");
            const unsigned og = xb_add(&bar[XB_TOP], 1u);
            const unsigned tg = og / nx;
            if (og + 1u == (tg + 1u) * nx) xb_add(&bar[XB_TOPGEN], 1u);
            else XB_SPIN(xb_ld(&bar[XB_TOPGEN]) == tg, bar);
            __builtin_amdgcn_fence(__ATOMIC_ACQUIRE, "agent");
            xb_add(&bar[XB_XGEN(b.x)], 1u);
            asm volatile("s_waitcnt vmcnt(0)" ::: "memory");
        } else {
            XB_SPIN(xb_ld(&bar[XB_XGEN(b.x)]) == gen, bar);
            __builtin_amdgcn_fence(__ATOMIC_ACQUIRE, "agent");
            asm volatile("s_waitcnt vmcnt(0)" ::: "memory");
        }
    }
    __syncthreads();
}
#define CAS __attribute__((address_space(4)))
struct Frame {
    LAS unsigned char* lds;
    volatile LAS unsigned* MISC;
    gu32* ctl;
    int tid, lane, wave;
    int vcu, G;
    const CAS char* kp;
};
struct Ptrs {
    const float *x, *c, *w_ada, *b_ada, *g_pre, *w_in, *q_norm_g, *k_norm_g, *taps, *w_up, *w0, *a_up, *a0, *k_k, *k_a, *r_k, *gn_w, *gn_b, *w_out, *g_post;
    float* out;
    float *MOD, *ROPE, *BON, *Y, *OUTPRE;
    bf16 *Win_t, *Wout_t, *XN, *QB, *KB, *VB, *GATT, *RKV, *WA, *GRW, *MIX;
};
__device__ __forceinline__ Ptrs load_ptrs(const Frame& F) {
    const CAS char* kp = F.kp; asm volatile("" : "+s"(kp));
    const float* const CAS* in = (const float* const CAS*)kp;
    Ptrs P;
    P.x = in[0]; P.c = in[1]; P.w_ada = in[2]; P.b_ada = in[3]; P.g_pre = in[4]; P.w_in = in[5]; P.q_norm_g = in[6]; P.k_norm_g = in[7];
    P.taps = in[8]; P.w_up = in[9]; P.w0 = in[10]; P.a_up = in[11]; P.a0 = in[12]; P.k_k = in[13]; P.k_a = in[14]; P.r_k = in[15];
    P.gn_w = in[16]; P.gn_b = in[17]; P.w_out = in[18]; P.g_post = in[19];
    P.out = *(float* const CAS*)(kp + 160); unsigned char* ws = *(unsigned char* const CAS*)(kp + 168);
    P.MOD = (float*)(ws + WS_MOD); P.ROPE = (float*)(ws + WS_ROPE); P.BON = (float*)(ws + WS_BON); P.Y = (float*)(ws + WS_Y); P.OUTPRE = (float*)(ws + WS_OUTPRE);
    P.Win_t = (bf16*)(ws + WS_WIN); P.Wout_t = (bf16*)(ws + WS_WOUT); P.XN = (bf16*)(ws + WS_XN); P.MIX = (bf16*)(ws + WS_XN);
    P.QB = (bf16*)(ws + WS_Q); P.KB = (bf16*)(ws + WS_K); P.VB = (bf16*)(ws + WS_V); P.GATT = (bf16*)(ws + WS_GATT); P.RKV = (bf16*)(ws + WS_RKV); P.WA = (bf16*)(ws + WS_WA); P.GRW = (bf16*)(ws + WS_GRW);
    return P;
}

__device__ __forceinline__ float wave_sum(float v) {
#pragma unroll
    for (int o = 1; o < 64; o <<= 1) v += __shfl_xor(v, o);
    return v;
}
__device__ __forceinline__ float bf2f(bf16 v) { return __uint_as_float((unsigned)v << 16); }
__device__ __forceinline__ float sigmoidf_(float v) { return 1.0f / (1.0f + __expf(-v)); }
__device__ __forceinline__ float siluf_(float v) { return v / (1.0f + __expf(-v)); }

__device__ __forceinline__ int win_dest_row(int n) {
    if (n < 640) {
        const int hd = n >> 6, d = n & 63, tile = hd >> 2, wc = hd & 3, bj = d >> 5, dl = d & 31, nn = dl >> 4, fq = (dl >> 2) & 3, e = dl & 3;
        return tile * 256 + 128 * bj + 32 * wc + 8 * fq + 4 * nn + e;
    }
    if (n < 768) { const int j = n - 640, vh = j >> 6, d = j & 63; return 2 * 256 + 128 * (d >> 5) + 32 * (2 + vh) + (d & 31); }
    if (n < 1280) return 3 * 256 + (n - 768);
    if (n < 2816) return 5 * 256 + (n - 1280);
    if (n < 2944) return 11 * 256 + (n - 2816);
    return 12 * 256 + (n - 2944);
}
template <bool PERMUTE>
__device__ __forceinline__ void p0_transpose_item(const float* W, int K, int N, bf16* WT, LAS float* scr, int item, int lane) {
    const int nblk = N / 32, kb = item / nblk, nb = item % nblk, k0 = 64 * kb, n0 = 32 * nb;
#pragma unroll 8
    for (int i = 0; i < 32; ++i) { const int kk = 2 * i + (lane >> 5); scr[kk * 33 + (lane & 31)] = W[(size_t)(k0 + kk) * N + n0 + (lane & 31)]; }
    LDS_WAIT(); asm volatile("" ::: "memory");
    const int c = lane & 7;
#pragma unroll
    for (int j = 0; j < 4; ++j) { const int n = (lane >> 3) + 8 * j; const LAS float* s = scr + (8 * c) * 33 + n;
        v4u o; o.x = pk2(s[0 * 33], s[1 * 33]); o.y = pk2(s[2 * 33], s[3 * 33]); o.z = pk2(s[4 * 33], s[5 * 33]); o.w = pk2(s[6 * 33], s[7 * 33]);
        const int drow = PERMUTE ? win_dest_row(n0 + n) : (n0 + n);
        *(GAS v4u*)(WT + (size_t)drow * K + k0 + 8 * c) = o; }
    LDS_WAIT(); asm volatile("" ::: "memory");
}
__device__ __forceinline__ void p0_mod_item(Frame& F, const Ptrs& P, LAS float* scr, int item) {
    const int cb = item >> 3, ks = item & 7, col = cb * 64 + F.lane, k0 = ks * 128;
    for (int i = F.lane; i < 16 * 128; i += 64) { const int b = i >> 7, k = i & 127; scr[i] = siluf_(P.c[b * D + k0 + k]); }
    LDS_WAIT(); asm volatile("" ::: "memory");
    float acc[16];
#pragma unroll
    for (int b = 0; b < 16; ++b) acc[b] = 0.f;
    for (int k = 0; k < 128; k += 4) {
        float w[4];
#pragma unroll
        for (int j = 0; j < 4; ++j) w[j] = P.w_ada[(size_t)(k0 + k + j) * (3 * D) + col];
#pragma unroll
        for (int b = 0; b < 16; ++b) { const f32x4 s = *(const LAS f32x4*)(scr + b * 128 + k); acc[b] += s[0] * w[0] + s[1] * w[1] + s[2] * w[2] + s[3] * w[3]; }
    }
    const float bias = (ks == 0) ? P.b_ada[col] : 0.f;
#pragma unroll
    for (int b = 0; b < 16; ++b) atomicAdd(P.MOD + b * (3 * D) + col, acc[b] + bias);
    LDS_WAIT(); asm volatile("" ::: "memory");
}
__device__ __forceinline__ void p0_prologue(Frame& F) {
    const Ptrs P = load_ptrs(F);
    LAS float* scr = (LAS float*)(F.lds + RING_OFF + F.wave * 16384);
    const int gw = F.vcu * NWAVES + F.wave, NGW = F.G * NWAVES;
    constexpr int I_IN = (D / 64) * (NIN / 32), I_OUT = (D / 64) * (D / 32), I_MOD = 48 * 8;
    constexpr int NITEMS = I_IN + I_OUT + I_MOD;
    for (int it0 = gw; it0 < NITEMS; it0 += NGW) {
        int r = NITEMS - 1 - it0;
        if (r >= I_IN + I_OUT) { p0_mod_item(F, P, scr, r - I_IN - I_OUT); continue; }
        if (r < I_IN) { p0_transpose_item<true>(P.w_in, D, NIN, P.Win_t, scr, r, F.lane); continue; } r -= I_IN;
        p0_transpose_item<false>(P.w_out, D, D, P.Wout_t, scr, r, F.lane);
    }
    { const int gt = F.vcu * (NWAVES * 64) + F.tid, NGT = F.G * NWAVES * 64;
      for (int i = gt; i < 16384; i += NGT) *(GAS v4u*)(P.Win_t + (size_t)(11 * 256 + 128) * D + (size_t)i * 8) = (v4u){0u, 0u, 0u, 0u};
      for (int i = gt; i < 1024; i += NGT) { const int pos = i >> 4, fi = i & 15; const float inv = powf(10000.0f, -(float)fi / 16.0f); const float ang = (float)pos * inv;
          P.ROPE[i] = cosf(ang); P.ROPE[1024 + i] = sinf(ang); } }
}
__device__ __forceinline__ void p1_xn(Frame& F) {
    const Ptrs P = load_ptrs(F);
    const int gw = F.vcu * NWAVES + F.wave, NGW = F.G * NWAVES;
    for (int grp = gw; grp < M / 16; grp += NGW) {
        const int m0 = grp * 16, b = m0 / T;
        f32x4 gs[4], sh[4];
#pragma unroll
        for (int j = 0; j < 4; ++j) { const int d0 = 256 * j + 4 * F.lane; const f32x4 g = *(const GAS f32x4*)(P.g_pre + d0), sc = *(const GAS f32x4*)(P.MOD + b * 3 * D + D + d0);
            gs[j] = g * (sc + 1.0f); sh[j] = *(const GAS f32x4*)(P.MOD + b * 3 * D + d0); }
        for (int r = 0; r < 16; ++r) {
            const GAS f32x4* xr = (const GAS f32x4*)(P.x + (size_t)(m0 + r) * D) + F.lane;
            f32x4 v[4]; float s = 0.f;
#pragma unroll
            for (int j = 0; j < 4; ++j) { v[j] = xr[64 * j]; s += (v[j].x * v[j].x + v[j].y * v[j].y) + (v[j].z * v[j].z + v[j].w * v[j].w); }
            const float rstd = 1.f / sqrtf(wave_sum(s) * (1.f / D) + NORM_EPS);
            GAS unsigned long long* o8 = (GAS unsigned long long*)(P.XN + (size_t)(m0 + r) * D) + F.lane;
#pragma unroll
            for (int j = 0; j < 4; ++j) { const f32x4 h = v[j] * rstd * gs[j] + sh[j];
                o8[64 * j] = (unsigned long long)pk2(h.x, h.y) | ((unsigned long long)pk2(h.z, h.w) << 32); }
        }
    }
}

struct EpiInProj {
    static constexpr bool PERM = true, AFTER_DRAIN = false;
    bf16 *Q, *K, *V, *GATT, *RKV, *WA, *GRW; const float *qg, *kg, *rope; float c2;
    __device__ __forceinline__ void operator()(const f32x4 (&acc)[2][2][4][2], const pg8::Unit& u, int wr, int wc, int fr, int fq) const {
        const int pn = u.pn, row0 = u.pm * 256 + wr * 64 + fr;
        if (pn >= 3) {
            bf16* base; int ldc, colt; bool act;
            if (pn < 5) { base = GATT; ldc = 512; colt = (pn - 3) * 256; act = true; }
            else if (pn < 11) { base = RKV; ldc = 1536; colt = (pn - 5) * 256; act = false; }
            else if (pn == 11) { base = WA; ldc = 128; colt = 0; act = false; }
            else { base = GRW; ldc = 512; colt = (pn - 12) * 256; act = true; }
            const int col0 = colt + wc * 32 + 8 * fq;
#pragma unroll
            for (int ai = 0; ai < 2; ++ai)
#pragma unroll
                for (int m = 0; m < 4; ++m) { bf16* rowp = base + (size_t)(row0 + ai * 128 + m * 16) * ldc + col0;
#pragma unroll
                    for (int bj = 0; bj < 2; ++bj) { if (pn == 11 && bj == 1) continue;
                        f32x4 v0 = acc[ai][bj][m][0], v1 = acc[ai][bj][m][1];
                        if (act) { v0 = (f32x4){siluf_(v0[0]), siluf_(v0[1]), siluf_(v0[2]), siluf_(v0[3])}; v1 = (f32x4){siluf_(v1[0]), siluf_(v1[1]), siluf_(v1[2]), siluf_(v1[3])}; }
                        v4u w; w.x = pg8::cvt_pk_bf16(v0[0], v0[1]); w.y = pg8::cvt_pk_bf16(v0[2], v0[3]); w.z = pg8::cvt_pk_bf16(v1[0], v1[1]); w.w = pg8::cvt_pk_bf16(v1[2], v1[3]);
                        *(v4u*)(rowp + bj * 128) = w; } }
        } else if (pn == 2 && wc >= 2) {
#pragma unroll
            for (int ai = 0; ai < 2; ++ai)
#pragma unroll
                for (int m = 0; m < 4; ++m) { bf16* rowp = V + (size_t)(row0 + ai * 128 + m * 16) * 128 + (wc - 2) * 64 + 8 * fq;
#pragma unroll
                    for (int bj = 0; bj < 2; ++bj) { const f32x4 v0 = acc[ai][bj][m][0], v1 = acc[ai][bj][m][1];
                        v4u w; w.x = pg8::cvt_pk_bf16(v0[0], v0[1]); w.y = pg8::cvt_pk_bf16(v0[2], v0[3]); w.z = pg8::cvt_pk_bf16(v1[0], v1[1]); w.w = pg8::cvt_pk_bf16(v1[2], v1[3]);
                        *(v4u*)(rowp + bj * 32) = w; } }
        } else {
            const bool isq = pn < 2; const float* g = isq ? qg : kg; const float sc = isq ? c2 : 1.0f;
            bf16* base = isq ? (Q + (pn * 4 + wc) * 64) : (K + wc * 64); const int ldc = isq ? 512 : 128;
            f32x4 gv[2][2];
#pragma unroll
            for (int bj = 0; bj < 2; ++bj)
#pragma unroll
                for (int n = 0; n < 2; ++n) gv[bj][n] = *(const f32x4*)(g + 32 * bj + 16 * n + 4 * fq);
#pragma unroll
            for (int ai = 0; ai < 2; ++ai)
#pragma unroll
                for (int m = 0; m < 4; ++m) { const int row = row0 + ai * 128 + m * 16, t = row & (T - 1);
                    float ss = 0.f;
#pragma unroll
                    for (int bj = 0; bj < 2; ++bj)
#pragma unroll
                        for (int n = 0; n < 2; ++n) { const f32x4 v = acc[ai][bj][m][n]; ss += (v[0] * v[0] + v[1] * v[1]) + (v[2] * v[2] + v[3] * v[3]); }
                    ss += __shfl_xor(ss, 16); ss += __shfl_xor(ss, 32);
                    const float rstd = sc / sqrtf(ss * (1.0f / 64.0f) + NORM_EPS);
#pragma unroll
                    for (int bj = 0; bj < 2; ++bj) { const int pos = bj ? (t & 63) : (t >> 6);
                        const f32x4 cs = *(const f32x4*)(rope + pos * 16 + 4 * fq), sn = *(const f32x4*)(rope + 1024 + pos * 16 + 4 * fq);
                        const f32x4 x1 = acc[ai][bj][m][0] * rstd * gv[bj][0], x2 = acc[ai][bj][m][1] * rstd * gv[bj][1];
                        const f32x4 y1 = x1 * cs - x2 * sn, y2 = x2 * cs + x1 * sn;
                        v4u w; w.x = pg8::cvt_pk_bf16(y1[0], y1[1]); w.y = pg8::cvt_pk_bf16(y1[2], y1[3]); w.z = pg8::cvt_pk_bf16(y2[0], y2[1]); w.w = pg8::cvt_pk_bf16(y2[2], y2[3]);
                        *(v4u*)(base + (size_t)row * ldc + 32 * bj + 8 * fq) = w; } }
        }
    }
};
struct EpiF32 {
    static constexpr bool PERM = false, AFTER_DRAIN = false;
    float* O; int ldc;
    __device__ __forceinline__ void operator()(const f32x4 (&acc)[2][2][4][2], const pg8::Unit& u, int wr, int wc, int fr, int fq) const {
        const int row0 = u.pm * 256 + wr * 64 + fr, col0 = u.pn * 256 + wc * 32 + 4 * fq;
#pragma unroll
        for (int ai = 0; ai < 2; ++ai)
#pragma unroll
            for (int m = 0; m < 4; ++m) { float* rowp = O + (size_t)(row0 + ai * 128 + m * 16) * ldc + col0;
#pragma unroll
                for (int bj = 0; bj < 2; ++bj)
#pragma unroll
                    for (int n = 0; n < 2; ++n) *(f32x4*)(rowp + bj * 128 + n * 16) = acc[ai][bj][m][n]; }
    }
};

constexpr int TC = 32;
__device__ __forceinline__ void rwkv_scan_seq(Frame& F, int unit) {
    const Ptrs P = load_ptrs(F);
    const int z = unit >> 7, b = (unit >> 3) & 15, h = unit & 7, tid = F.tid, lane = F.lane;
    LAS float* L = (LAS float*)(F.lds + RING_OFF);
    LAS float* WUP = L;              LAS float* AUP = L + 4096;
    LAS float* RR = L + 8192;        LAS float* KR = RR + 2048;  LAS float* VV = KR + 2048;  LAS float* WD = VV + 2048;  LAS float* AD = WD + 2048;
    LAS float* WW = AD + 2048;       LAS float* KK = WW + 2048;  LAS float* AKK = KK + 2048; LAS float* KT = AKK + 2048;
    LAS float* YO = KT + 2048;       LAS float* BO = YO + 2048;
    for (int i = tid; i < 4096; i += 512) { const int r = i >> 6, c = i & 63; WUP[i] = P.w_up[(size_t)(z * 64 + r) * RW + h * 64 + c]; AUP[i] = P.a_up[(size_t)(z * 64 + r) * RW + h * 64 + c]; }
    float S[8];
#pragma unroll
    for (int j = 0; j < 8; ++j) S[j] = 0.f;
    const int c = tid & 63, sg = tid >> 6;
    const float w0c = P.w0[z * RW + h * 64 + c], a0c = P.a0[z * RW + h * 64 + c], kkc = P.k_k[h * 64 + c], kac = P.k_a[h * 64 + c], rkc = P.r_k[h * 64 + c];
    const int vrow = tid >> 3, ks = tid & 7;
    __syncthreads();
    for (int ch = 0; ch < T / TC; ++ch) {
        for (int i = tid; i < 5 * 2048; i += 512) {
            const int arr = i >> 11, rem = i & 2047, sl = rem >> 6, cc = rem & 63, s = ch * TC + sl, t = z ? (T - 1 - s) : s;
            const size_t row = (size_t)b * T + t;
            const bf16* src; int pitch, tapc;
            if (arr < 3) { src = P.RKV + arr * 512 + h * 64 + cc; pitch = 1536; tapc = arr * 512 + h * 64 + cc; }
            else { src = P.WA + (arr - 3) * 64 + cc; pitch = 128; tapc = 1536 + (arr - 3) * 64 + cc; }
            float val = P.taps[RSW + tapc] * bf2f(src[row * pitch]);
            if (t > 0) val += P.taps[tapc] * bf2f(src[(row - 1) * pitch]);
            if (t < T - 1) val += P.taps[2 * RSW + tapc] * bf2f(src[(row + 1) * pitch]);
            if (arr == 3) val = tanhf(val);
            RR[i] = val;
        }
        __syncthreads();
        {
            float wl[4], al[4];
#pragma unroll
            for (int j = 0; j < 4; ++j) { wl[j] = w0c; al[j] = a0c; }
            for (int r = 0; r < 64; r += 4) {
                float wu[4], au[4];
#pragma unroll
                for (int q = 0; q < 4; ++q) { wu[q] = WUP[(r + q) * 64 + c]; au[q] = AUP[(r + q) * 64 + c]; }
#pragma unroll
                for (int j = 0; j < 4; ++j) { const f32x4 wd = *(const LAS f32x4*)(WD + (4 * sg + j) * 64 + r), ad = *(const LAS f32x4*)(AD + (4 * sg + j) * 64 + r);
                    wl[j] += wd[0] * wu[0] + wd[1] * wu[1] + wd[2] * wu[2] + wd[3] * wu[3]; al[j] += ad[0] * au[0] + ad[1] * au[1] + ad[2] * au[2] + ad[3] * au[3]; }
            }
#pragma unroll
            for (int j = 0; j < 4; ++j) { const int sl = 4 * sg + j;
                const float w = __expf(-DECAY_SCALE * sigmoidf_(wl[j])), a = sigmoidf_(al[j]);
                const float kraw = KR[sl * 64 + c], kkv = kraw * kkc;
                const float ssq = wave_sum(kkv * kkv), kkn = kkv / sqrtf(ssq + L2_EPS);
                const float kt = kraw * (1.0f + (a - 1.0f) * kac);
                const float bon = wave_sum(RR[sl * 64 + c] * kt * rkc);
                WW[sl * 64 + c] = w; KK[sl * 64 + c] = kkn; AKK[sl * 64 + c] = a * kkn; KT[sl * 64 + c] = kt;
                if (lane == 0) BO[sl] = bon; }
        }
        __syncthreads();
        for (int sl = 0; sl < TC; ++sl) {
            const LAS float* pw = WW + sl * 64 + ks * 8; const LAS float* pk = KK + sl * 64 + ks * 8; const LAS float* pa = AKK + sl * 64 + ks * 8;
            const LAS float* pt = KT + sl * 64 + ks * 8; const LAS float* pr = RR + sl * 64 + ks * 8;
            const f32x4 w0v = *(const LAS f32x4*)pw, w1v = *(const LAS f32x4*)(pw + 4), k0v = *(const LAS f32x4*)pk, k1v = *(const LAS f32x4*)(pk + 4);
            const f32x4 a0v = *(const LAS f32x4*)pa, a1v = *(const LAS f32x4*)(pa + 4), t0v = *(const LAS f32x4*)pt, t1v = *(const LAS f32x4*)(pt + 4);
            const f32x4 r0v = *(const LAS f32x4*)pr, r1v = *(const LAS f32x4*)(pr + 4);
            const float vv = VV[sl * 64 + vrow];
            float sa = (S[0] * k0v[0] + S[1] * k0v[1]) + (S[2] * k0v[2] + S[3] * k0v[3]) + (S[4] * k1v[0] + S[5] * k1v[1]) + (S[6] * k1v[2] + S[7] * k1v[3]);
            sa += __shfl_xor(sa, 1); sa += __shfl_xor(sa, 2); sa += __shfl_xor(sa, 4);
#pragma unroll
            for (int j = 0; j < 4; ++j) { S[j] = S[j] * w0v[j] - sa * a0v[j] + vv * t0v[j]; S[4 + j] = S[4 + j] * w1v[j] - sa * a1v[j] + vv * t1v[j]; }
            float y = (S[0] * r0v[0] + S[1] * r0v[1]) + (S[2] * r0v[2] + S[3] * r0v[3]) + (S[4] * r1v[0] + S[5] * r1v[1]) + (S[6] * r1v[2] + S[7] * r1v[3]);
            y += __shfl_xor(y, 1); y += __shfl_xor(y, 2); y += __shfl_xor(y, 4);
            if (ks == 0) YO[sl * 64 + vrow] = y;
        }
        __syncthreads();
        for (int i = tid; i < 2048; i += 512) { const int sl = i >> 6, vc = i & 63, s = ch * TC + sl, t = z ? (T - 1 - s) : s;
            P.Y[((size_t)z * M + (size_t)b * T + t) * RW + h * 64 + vc] = YO[i]; }
        if (tid < TC) { const int s = ch * TC + tid, t = z ? (T - 1 - s) : s; P.BON[((size_t)z * M + (size_t)b * T + t) * 8 + h] = BO[tid]; }
    }
}
typedef unsigned u32x2 __attribute__((ext_vector_type(2)));
__device__ __forceinline__ unsigned cvtpk(float lo, float hi) { typedef float f2_ __attribute__((ext_vector_type(2))); typedef __bf16 b2_ __attribute__((ext_vector_type(2))); f2_ v = {lo, hi}; b2_ b = __builtin_convertvector(v, b2_); return __builtin_bit_cast(unsigned, b); }
__device__ __forceinline__ bf16x8 frag_lo(f32x4 x) { v4u w = {cvtpk(x[0], x[1]), cvtpk(x[2], x[3]), 0u, 0u}; return __builtin_bit_cast(bf16x8, w); }
__device__ __forceinline__ bf16x8 frag_2(f32x4 x, f32x4 y) { v4u w = {cvtpk(x[0], x[1]), cvtpk(x[2], x[3]), cvtpk(y[0], y[1]), cvtpk(y[2], y[3])}; return __builtin_bit_cast(bf16x8, w); }
__device__ __forceinline__ bf16x8 frag_lo_u(u32x2 x) { v4u w = {x[0], x[1], 0u, 0u}; return __builtin_bit_cast(bf16x8, w); }
__device__ __forceinline__ f32x4 mfma16(bf16x8 a, bf16x8 b, f32x4 c) { return __builtin_amdgcn_mfma_f32_16x16x32_bf16(a, b, c, 0, 0, 0); }
__device__ __forceinline__ float fsig(float v) { return __builtin_amdgcn_rcpf(1.0f + __builtin_amdgcn_exp2f(-1.4426950408889634f * v)); }
__device__ __forceinline__ int kpos(int k) { return 32 * (k >> 5) + 8 * ((k >> 2) & 3) + 4 * ((k >> 4) & 1) + (k & 3); }
constexpr int O_WUPT = 0, O_AUPT = 8192, O_TAPS = 16384, O_CONST = 20480, O_RNS = 22528, O_BONS = 22784, O_GC = 23040, O_SHR = 24576, O_SHK = 40960, O_TW = 57344, O_AD = 65536, O_VT = 73728,
              O_AT = 81920, O_RT = 90112, O_BT = 98304, O_KT = 106496, O_BK = 114688, O_TA = 131072, O_AAK = 133120, O_ARBK = 135168, O_SCAN_END = 139264, O_YST = O_SHR;
constexpr float LOG2E = 1.4426950408889634f;
__device__ __forceinline__ void rwkv_scan_chunked(Frame& F, int unit) {
    const Ptrs P = load_ptrs(F);
    const int z = unit >> 7, b = (unit >> 3) & 15, h = unit & 7, tid0 = F.tid, w = F.wave;
#define OPAQUE_IDS int tid = tid0; asm volatile("" : "+v"(tid)); const int lane = tid & 63, fr = lane & 15, fq = lane >> 4; (void)lane; (void)fr; (void)fq;
    LAS unsigned char* L = F.lds;
    LAS float* TAPS = (LAS float*)(L + O_TAPS); LAS float* CST = (LAS float*)(L + O_CONST); LAS float* RNS = (LAS float*)(L + O_RNS); LAS float* BONS = (LAS float*)(L + O_BONS); LAS float* GC = (LAS float*)(L + O_GC);
    LAS float* SHR = (LAS float*)(L + O_SHR); LAS float* SHK = (LAS float*)(L + O_SHK); LAS float* YST = (LAS float*)(L + O_YST);
    { OPAQUE_IDS
    for (int i = tid; i < 4096; i += 512) { const int ch = i >> 6, rk = i & 63;
        ((LAS bf16*)(L + O_WUPT))[i] = (bf16)f2bf(P.w_up[(size_t)(z * 64 + rk) * RW + h * 64 + ch]); ((LAS bf16*)(L + O_AUPT))[i] = (bf16)f2bf(P.a_up[(size_t)(z * 64 + rk) * RW + h * 64 + ch]); }
    for (int i = tid; i < 960; i += 512) { const int j = i / 320, idx = i % 320; const int col = idx < 192 ? (idx >> 6) * 512 + h * 64 + (idx & 63) : 1536 + (idx - 192); TAPS[i] = P.taps[j * RSW + col]; }
    if (tid < 64) { CST[tid] = P.k_k[h * 64 + tid]; CST[64 + tid] = P.k_a[h * 64 + tid]; CST[128 + tid] = P.r_k[h * 64 + tid]; CST[192 + tid] = P.w0[z * RW + h * 64 + tid]; CST[256 + tid] = P.a0[z * RW + h * 64 + tid]; RNS[tid] = 0.f; }
    }
    f32x4 St[4];
#pragma unroll
    for (int i = 0; i < 4; ++i) St[i] = (f32x4){0.f, 0.f, 0.f, 0.f};
    __syncthreads();
    for (int n = 0; n < T / 64; ++n) {
        const int tlo = z ? (T - 64 * (n + 1)) : 64 * n;
        { OPAQUE_IDS
        if (tid < 320) {
            const int cchunk = tid % 40, rg = tid / 40, arr = cchunk < 24 ? (cchunk >> 3) : 3, cc = cchunk & 7;
            const bf16* src; size_t pitch;
            if (arr < 3) { src = P.RKV + arr * 512 + h * 64 + cc * 8; pitch = 1536; } else { src = P.WA + (cchunk - 24) * 8; pitch = 128; }
            v4u x[10];
#pragma unroll
            for (int i = 0; i < 10; ++i) { const int t = tlo - 1 + 8 * rg + i; x[i] = (t >= 0 && t < T) ? *(const GAS v4u*)(src + ((size_t)b * T + t) * pitch) : (v4u){0u, 0u, 0u, 0u}; }
            float tp[3][8];
#pragma unroll
            for (int j = 0; j < 3; ++j) { const f32x4 a = *(const LAS f32x4*)(TAPS + j * 320 + cchunk * 8), c = *(const LAS f32x4*)(TAPS + j * 320 + cchunk * 8 + 4);
                tp[j][0] = a[0]; tp[j][1] = a[1]; tp[j][2] = a[2]; tp[j][3] = a[3]; tp[j][4] = c[0]; tp[j][5] = c[1]; tp[j][6] = c[2]; tp[j][7] = c[3]; }
            float kc[8];
            if (arr == 1) {
#pragma unroll
                for (int e = 0; e < 8; ++e) kc[e] = CST[cc * 8 + e]; }
            unsigned vpk[8][4];
#pragma unroll
            for (int o = 0; o < 8; ++o) {
                const int sl = z ? (63 - 8 * rg - o) : (8 * rg + o);
                float val[8];
#pragma unroll
                for (int e = 0; e < 8; ++e) { const int d = e >> 1;
                    const float x0 = (e & 1) ? __uint_as_float(x[o][d] & 0xffff0000u) : __uint_as_float(x[o][d] << 16);
                    const float x1 = (e & 1) ? __uint_as_float(x[o + 1][d] & 0xffff0000u) : __uint_as_float(x[o + 1][d] << 16);
                    const float x2 = (e & 1) ? __uint_as_float(x[o + 2][d] & 0xffff0000u) : __uint_as_float(x[o + 2][d] << 16);
                    val[e] = tp[0][e] * x0 + tp[1][e] * x1 + tp[2][e] * x2; }
                if (arr == 0) { *(LAS f32x4*)(SHR + sl * 64 + cc * 8) = (f32x4){val[0], val[1], val[2], val[3]}; *(LAS f32x4*)(SHR + sl * 64 + cc * 8 + 4) = (f32x4){val[4], val[5], val[6], val[7]}; }
                else if (arr == 1) { *(LAS f32x4*)(SHK + sl * 64 + cc * 8) = (f32x4){val[0], val[1], val[2], val[3]}; *(LAS f32x4*)(SHK + sl * 64 + cc * 8 + 4) = (f32x4){val[4], val[5], val[6], val[7]};
                    float ss = 0.f;
#pragma unroll
                    for (int e = 0; e < 8; ++e) { const float q = val[e] * kc[e]; ss += q * q; }
                    __hip_atomic_fetch_add(RNS + sl, ss, __ATOMIC_RELAXED, __HIP_MEMORY_SCOPE_WORKGROUP); }
                else if (arr == 2) {
#pragma unroll
                    for (int e = 0; e < 8; ++e) { const unsigned hb = f2bf(val[e]); if (o & 1) vpk[e][o >> 1] |= hb << 16; else vpk[e][o >> 1] = hb; }
                }
                else { const bool iswd = cchunk < 32;
                    if (iswd) {
#pragma unroll
                        for (int e = 0; e < 8; ++e) { const float ex = __builtin_amdgcn_exp2f(2.0f * LOG2E * val[e]); val[e] = 1.0f - 2.0f * __builtin_amdgcn_rcpf(ex + 1.0f); } }
                    v4u wv = {cvtpk(val[0], val[1]), cvtpk(val[2], val[3]), cvtpk(val[4], val[5]), cvtpk(val[6], val[7])};
                    *(LAS v4u*)(L + (iswd ? O_TW : O_AD) + sl * 128 + (cchunk & 7) * 16) = wv; }
            }
            if (arr == 2) { const int sl0 = z ? (56 - 8 * rg) : 8 * rg;
#pragma unroll
                for (int e = 0; e < 8; ++e) { v4u o4;
                    if (z) o4 = (v4u){(vpk[e][3] >> 16) | (vpk[e][3] << 16), (vpk[e][2] >> 16) | (vpk[e][2] << 16), (vpk[e][1] >> 16) | (vpk[e][1] << 16), (vpk[e][0] >> 16) | (vpk[e][0] << 16)};
                    else o4 = (v4u){vpk[e][0], vpk[e][1], vpk[e][2], vpk[e][3]};
                    *(LAS v4u*)(L + O_VT + (cc * 8 + e) * 128 + sl0 * 2) = o4; } }
        } else if (tid < 384) BONS[tid - 320] = 0.f;
        }
        __syncthreads();
        { OPAQUE_IDS
            const int mt = w >> 1;
            const bf16x8 tw0 = *(const LAS bf16x8*)(L + O_TW + (16 * mt + fr) * 128 + fq * 16), tw1 = *(const LAS bf16x8*)(L + O_TW + (16 * mt + fr) * 128 + 64 + fq * 16);
            const bf16x8 ad0 = *(const LAS bf16x8*)(L + O_AD + (16 * mt + fr) * 128 + fq * 16), ad1 = *(const LAS bf16x8*)(L + O_AD + (16 * mt + fr) * 128 + 64 + fq * 16);
#pragma unroll
            for (int gi = 0; gi < 2; ++gi) {
                const int ng = 2 * (w & 1) + gi, ch = 16 * ng + fr, cp = kpos(ch);
                const bf16x8 wu0 = *(const LAS bf16x8*)(L + O_WUPT + ch * 128 + fq * 16), wu1 = *(const LAS bf16x8*)(L + O_WUPT + ch * 128 + 64 + fq * 16);
                const bf16x8 au0 = *(const LAS bf16x8*)(L + O_AUPT + ch * 128 + fq * 16), au1 = *(const LAS bf16x8*)(L + O_AUPT + ch * 128 + 64 + fq * 16);
                f32x4 accw = mfma16(tw0, wu0, (f32x4){0.f, 0.f, 0.f, 0.f}); accw = mfma16(tw1, wu1, accw);
                f32x4 acca = mfma16(ad0, au0, (f32x4){0.f, 0.f, 0.f, 0.f}); acca = mfma16(ad1, au1, acca);
                const float kkc = CST[ch], kac = CST[64 + ch], rkc = CST[128 + ch], w0c = CST[192 + ch], a0c = CST[256 + ch];
                float lw[4], g[4];
#pragma unroll
                for (int r = 0; r < 4; ++r) lw[r] = -(DECAY_SCALE * LOG2E) * fsig(accw[r] + w0c);
                g[0] = lw[0]; g[1] = g[0] + lw[1]; g[2] = g[1] + lw[2]; g[3] = g[2] + lw[3];
                const float t0 = __shfl(g[3], fr), t1 = __shfl(g[3], fr + 16), t2 = __shfl(g[3], fr + 32), t3 = __shfl(g[3], fr + 48);
                const float ex = (fq > 0 ? t0 : 0.f) + (fq > 1 ? t1 : 0.f) + (fq > 2 ? t2 : 0.f), gC = (t0 + t1) + (t2 + t3);
                float bh[4], kh[4];
#pragma unroll
                for (int r = 0; r < 4; ++r) {
                    const int sl = 16 * mt + 4 * fq + r;
                    const float gi_ = ex + g[r], gm1 = gi_ - lw[r];
                    const float rsh = SHR[sl * 64 + ch], ksh = SHK[sl * 64 + ch], rn = 1.0f / sqrtf(RNS[sl] + L2_EPS);
                    const float a = fsig(acca[r] + a0c);
                    const float kk = ksh * kkc * rn, kt = ksh * (1.0f + (a - 1.0f) * kac), akk = a * kk;
                    const float e1 = __builtin_amdgcn_exp2f(gm1), e2 = __builtin_amdgcn_exp2f(-gi_), e3 = __builtin_amdgcn_exp2f(gi_), e4 = __builtin_amdgcn_exp2f(gC - gi_);
                    ((LAS bf16*)(L + O_AT))[sl * 64 + cp] = (bf16)f2bf(-kk * e1);
                    ((LAS bf16*)(L + O_BT))[sl * 64 + cp] = (bf16)f2bf(akk * e2);
                    ((LAS bf16*)(L + O_KT))[sl * 64 + cp] = (bf16)f2bf(kt * e2);
                    ((LAS bf16*)(L + O_RT))[sl * 64 + cp] = (bf16)f2bf(rsh * e3);
                    bh[r] = akk * e4; kh[r] = kt * e4;
                    float bon = rsh * kt * rkc;
                    bon += __shfl_xor(bon, 1); bon += __shfl_xor(bon, 2); bon += __shfl_xor(bon, 4); bon += __shfl_xor(bon, 8);
                    if (fr == 0) __hip_atomic_fetch_add(BONS + sl, bon, __ATOMIC_RELAXED, __HIP_MEMORY_SCOPE_WORKGROUP);
                }
                *(LAS v4u*)(L + O_BK + ((mt * 64 + ch) * 32 + fq * 8) * 2) = (v4u){cvtpk(bh[0], bh[1]), cvtpk(bh[2], bh[3]), cvtpk(kh[0], kh[1]), cvtpk(kh[2], kh[3])};
                if (fq == 0) GC[mt * 64 + ch] = __builtin_amdgcn_exp2f(gC);
            }
        }
        __syncthreads();
        { OPAQUE_IDS
            const int ck = w & 3; const f32x4 Z4 = (f32x4){0.f, 0.f, 0.f, 0.f};
            const int ro = (16 * ck + fr) * 128 + fq * 16;
            const bf16x8 af0 = *(const LAS bf16x8*)(L + O_AT + ro), af1 = *(const LAS bf16x8*)(L + O_AT + ro + 64);
            if (w < 4) {
                const bf16x8 bf0 = *(const LAS bf16x8*)(L + O_BT + ro), bf1 = *(const LAS bf16x8*)(L + O_BT + ro + 64);
                f32x4 X = mfma16(af0, bf0, Z4); X = mfma16(af1, bf1, X);
                f32x4 XT = mfma16(bf0, af0, Z4); XT = mfma16(bf1, af1, XT);
#pragma unroll
                for (int r = 0; r < 4; ++r) { if (!(fr < 4 * fq + r)) X[r] = 0.f; if (!(4 * fq + r < fr)) XT[r] = 0.f; }
                bf16x8 cx = frag_lo(X), cxt = frag_lo(XT);
                f32x4 X2 = mfma16(cxt, cx, Z4), X2T = mfma16(cx, cxt, Z4);
                bf16x8 c2 = frag_lo(X2), c2t = frag_lo(X2T);
                f32x4 X4 = mfma16(c2t, c2, Z4), X4T = mfma16(c2, c2t, Z4);
                bf16x8 c4 = frag_lo(X4), c4t = frag_lo(X4T);
                f32x4 X8 = mfma16(c4t, c4, Z4);
                f32x4 Q = XT;
#pragma unroll
                for (int r = 0; r < 4; ++r) if (4 * fq + r == fr) Q[r] += 1.0f;
                Q = mfma16(c2, frag_lo(Q), Q);
                Q = mfma16(c4, frag_lo(Q), Q);
                Q = mfma16(frag_lo(X8), frag_lo(Q), Q);
                *(LAS u32x2*)(L + O_TA + ((16 * ck + fr) * 16 + 4 * fq) * 2) = (u32x2){cvtpk(Q[0], Q[1]), cvtpk(Q[2], Q[3])};
            } else {
                const bf16x8 bf0 = *(const LAS bf16x8*)(L + O_BT + ro), bf1 = *(const LAS bf16x8*)(L + O_BT + ro + 64);
                const bf16x8 kf0 = *(const LAS bf16x8*)(L + O_KT + ro), kf1 = *(const LAS bf16x8*)(L + O_KT + ro + 64);
                const bf16x8 rf0 = *(const LAS bf16x8*)(L + O_RT + ro), rf1 = *(const LAS bf16x8*)(L + O_RT + ro + 64);
                f32x4 AkT = mfma16(kf0, af0, Z4); AkT = mfma16(kf1, af1, AkT);
                f32x4 RbT = mfma16(bf0, rf0, Z4); RbT = mfma16(bf1, rf1, RbT);
                f32x4 RkT = mfma16(kf0, rf0, Z4); RkT = mfma16(kf1, rf1, RkT);
#pragma unroll
                for (int r = 0; r < 4; ++r) { if (!(4 * fq + r < fr)) AkT[r] = 0.f; if (!(4 * fq + r <= fr)) { RbT[r] = 0.f; RkT[r] = 0.f; } }
                *(LAS u32x2*)(L + O_AAK + ((16 * ck + fr) * 16 + 4 * fq) * 2) = (u32x2){cvtpk(AkT[0], AkT[1]), cvtpk(AkT[2], AkT[3])};
                *(LAS v4u*)(L + O_ARBK + ((16 * ck + fr) * 32 + 8 * fq) * 2) = (v4u){cvtpk(RbT[0], RbT[1]), cvtpk(RbT[2], RbT[3]), cvtpk(RkT[0], RkT[1]), cvtpk(RkT[2], RkT[3])};
            }
        }
        __syncthreads();
        { OPAQUE_IDS
        if (w < 4) {
#pragma unroll 1
            for (int ck = 0; ck < 4; ++ck) {
                const int ro = (16 * ck + fr) * 128 + fq * 16; const f32x4 Z4 = (f32x4){0.f, 0.f, 0.f, 0.f};
                const bf16x8 af0 = *(const LAS bf16x8*)(L + O_AT + ro), af1 = *(const LAS bf16x8*)(L + O_AT + ro + 64);
                const bf16x8 rf0 = *(const LAS bf16x8*)(L + O_RT + ro), rf1 = *(const LAS bf16x8*)(L + O_RT + ro + 64);
                const bf16x8 aakf = frag_lo_u(*(const LAS u32x2*)(L + O_AAK + ((16 * ck + fr) * 16 + 4 * fq) * 2));
                const bf16x8 taf = frag_lo_u(*(const LAS u32x2*)(L + O_TA + ((16 * ck + fr) * 16 + 4 * fq) * 2));
                const bf16x8 arbkf = *(const LAS bf16x8*)(L + O_ARBK + ((16 * ck + fr) * 32 + 8 * fq) * 2);
                const u32x2 vv = *(const LAS u32x2*)(L + O_VT + (16 * w + fr) * 128 + (16 * ck + 4 * fq) * 2);
                const bf16x8 sb01 = frag_2(St[0], St[1]), sb23 = frag_2(St[2], St[3]);
                f32x4 U0 = mfma16(aakf, frag_lo_u(vv), Z4); U0 = mfma16(af0, sb01, U0); U0 = mfma16(af1, sb23, U0);
                const f32x4 U = mfma16(taf, frag_lo(U0), Z4);
                v4u uvw = {cvtpk(U[0], U[1]), cvtpk(U[2], U[3]), vv[0], vv[1]}; const bf16x8 uvb = __builtin_bit_cast(bf16x8, uvw);
                f32x4 Y = mfma16(rf0, sb01, Z4); Y = mfma16(rf1, sb23, Y); Y = mfma16(arbkf, uvb, Y);
#pragma unroll
                for (int kt = 0; kt < 4; ++kt) {
                    const f32x4 gc = *(const LAS f32x4*)(GC + ck * 64 + 16 * kt + 4 * fq);
                    const bf16x8 bkf = *(const LAS bf16x8*)(L + O_BK + ((ck * 64 + 16 * kt + fr) * 32 + 8 * fq) * 2);
                    St[kt] = mfma16(bkf, uvb, St[kt] * gc);
                }
#pragma unroll
                for (int r = 0; r < 4; ++r) YST[(16 * ck + 4 * fq + r) * 64 + 16 * w + fr] = Y[r];
            }
        } else if (w == 4) RNS[lane] = 0.f;
        }
        __syncthreads();
        { OPAQUE_IDS
        for (int i = tid; i < 4096; i += 512) { const int sl = i >> 6, vc = i & 63, t = z ? (tlo + 63 - sl) : (tlo + sl);
            P.Y[((size_t)z * M + (size_t)b * T + t) * RW + h * 64 + vc] = YST[i]; }
        if (tid < 64) { const int t = z ? (tlo + 63 - tid) : (tlo + tid); P.BON[((size_t)z * M + (size_t)b * T + t) * 8 + h] = BONS[tid]; }
        }
        __syncthreads();
    }
#undef OPAQUE_IDS
}
static_assert(O_SCAN_END <= RING_BYTES, "scan LDS");
__device__ __forceinline__ void mix_prep(Frame& F) {
    const Ptrs P = load_ptrs(F);
    const int gw = F.vcu * NWAVES + F.wave, NGW = F.G * NWAVES, lane = F.lane;
    for (int m = gw; m < M; m += NGW) {
        const int t = m & (T - 1);
#pragma unroll 2
        for (int h = 0; h < 8; ++h) {
            const int col = h * 64 + lane;
            const float y = P.Y[(size_t)m * RW + col] + P.Y[((size_t)M + m) * RW + col];
            const float mu = wave_sum(y) * (1.0f / 64.0f), dlt = y - mu, var = wave_sum(dlt * dlt) * (1.0f / 64.0f);
            const float yn = dlt / sqrtf(var + GN_EPS) * P.gn_w[col] + P.gn_b[col];
            const float bon = P.BON[(size_t)m * 8 + h] + P.BON[((size_t)M + m) * 8 + h];
            const int tapc = 1024 + col; const bf16* vsrc = P.RKV + 1024 + col;
            float vs = P.taps[RSW + tapc] * bf2f(vsrc[(size_t)m * 1536]);
            if (t > 0) vs += P.taps[tapc] * bf2f(vsrc[(size_t)(m - 1) * 1536]);
            if (t < T - 1) vs += P.taps[2 * RSW + tapc] * bf2f(vsrc[(size_t)(m + 1) * 1536]);
            const float o = (yn + bon * vs) * bf2f(P.GRW[(size_t)m * 512 + col]);
            P.MIX[(size_t)m * D + 512 + col] = (bf16)f2bf(o);
        }
    }
}
__device__ __forceinline__ void final_norm(Frame& F) {
    const Ptrs P = load_ptrs(F);
    const int gw = F.vcu * NWAVES + F.wave, NGW = F.G * NWAVES;
    for (int m = gw; m < M; m += NGW) {
        const int b = m / T;
        const GAS f32x4* orow = (const GAS f32x4*)(P.OUTPRE + (size_t)m * D) + F.lane; const GAS f32x4* xr = (const GAS f32x4*)(P.x + (size_t)m * D) + F.lane;
        f32x4 v[4]; float s = 0.f;
#pragma unroll
        for (int j = 0; j < 4; ++j) { v[j] = orow[64 * j]; s += (v[j].x * v[j].x + v[j].y * v[j].y) + (v[j].z * v[j].z + v[j].w * v[j].w); }
        const float rstd = 1.f / sqrtf(wave_sum(s) * (1.f / D) + NORM_EPS);
        GAS f32x4* o = (GAS f32x4*)(P.out + (size_t)m * D) + F.lane;
#pragma unroll
        for (int j = 0; j < 4; ++j) { const int d0 = 256 * j + 4 * F.lane; const f32x4 gp = *(const GAS f32x4*)(P.g_post + d0), gt = *(const GAS f32x4*)(P.MOD + b * 3 * D + 2 * D + d0);
            o[64 * j] = xr[64 * j] + gt * (v[j] * rstd * gp); }
    }
}

struct Args { const float* in[20]; float* out; unsigned char* ws; int ph_lo, ph_hi, li, pad; };
__global__ void __launch_bounds__(NWAVES * 64, 2) hyb_fwd(Args args) {
    extern __shared__ __attribute__((aligned(16))) unsigned char lds[];
    Frame F;
    F.lds = (LAS unsigned char*)lds;
    F.MISC = (volatile LAS unsigned*)(F.lds + MISC_OFF);
    F.tid = threadIdx.x; F.lane = F.tid & 63; F.wave = __builtin_amdgcn_readfirstlane(F.tid >> 6);
    F.G = gridDim.x; { const int bx = blockIdx.x; F.vcu = (F.G % 8 == 0) ? (bx % 8) * (F.G / 8) + bx / 8 : bx; }
#define GRID_BAR(seam) do { if (N_LAUNCHES == PER_PHASE) { if (F.tid == 0) __hip_atomic_store(F.ctl + CW_TMO, 0xBADBA0u | (unsigned)(seam), RLX_AGENT); } \
    else { xcd_barrier(bar); } } while (0)
    F.kp = (const CAS char*)__builtin_amdgcn_kernarg_segment_ptr();
    F.ctl = (gu32*)(args.ws + WS_CTL);
    for (int u = F.tid; u < (LDS_BYTES - LDSCTL_OFF) / 4; u += NWAVES * 64) ((LAS unsigned*)(F.lds + LDSCTL_OFF))[u] = 0u;
    __syncthreads();
    XcdBarrier bar; bar.bar = (unsigned*)(F.ctl + CW_BAR); bar.x = 0; bar.st = nullptr;
    if (N_LAUNCHES != PER_PHASE) bar = xcd_barrier_post((unsigned*)(F.ctl + CW_BAR), F.MISC + 8);

    const int lo = args.ph_lo, hi = args.ph_hi;
#define IN(k) (lo <= (k) && (k) < hi)
#define BOTH(k) (IN(k) && IN((k) + 1))
    if (IN(0)) { p0_prologue(F); if (BOTH(0)) GRID_BAR(0); }
    if (IN(1)) { p1_xn(F); if (BOTH(1)) GRID_BAR(1); }
    if (IN(2)) {
        const Ptrs P = load_ptrs(F);
        pg8::Gemm g{P.XN, P.Win_t, M, NINP, D}; pg8::StaticOrder S; S.init(M, NINP, F.G, (int)blockIdx.x);
        EpiInProj E{P.QB, P.KB, P.VB, P.GATT, P.RKV, P.WA, P.GRW, P.q_norm_g, P.k_norm_g, P.ROPE, attn_body::C2};
        pg8::gemm_phase<EpiInProj, pg8::StaticOrder, PG8_ALIGN, PG8_SP2>(F.lds + RING_OFF, g, S, E);
        if (BOTH(2)) GRID_BAR(2);
    }
    if (IN(3)) {
        { const Ptrs P = load_ptrs(F);
        const attn_body::AttnTensors AT{(const attn_body::bf16*)P.QB, (const attn_body::bf16*)P.KB, (const attn_body::bf16*)P.VB, (const attn_body::bf16*)P.GATT, (attn_body::bf16*)P.MIX};
        const attn_body::StaticOrder S((int)F.G, (int)blockIdx.x);
        attn_body::attn_phase<attn_body::StaticOrder>((char*)lds + RING_OFF, AT, S); }
        __syncthreads();
#if defined(RWKV_SEQ)
        for (int u = F.vcu; u < 256; u += F.G) { rwkv_scan_seq(F, u); __syncthreads(); }
#else
        for (int u = F.vcu; u < 256; u += F.G) { rwkv_scan_chunked(F, u); __syncthreads(); }
#endif
        if (BOTH(3)) GRID_BAR(3);
    }
    if (IN(4)) { mix_prep(F); if (BOTH(4)) GRID_BAR(4); }
    if (IN(5)) {
        const Ptrs P = load_ptrs(F);
        pg8::Gemm g{P.MIX, P.Wout_t, M, D, D}; pg8::StaticOrder S; S.init(M, D, F.G, (int)blockIdx.x);
        EpiF32 E{P.OUTPRE, D};
        pg8::gemm_phase<EpiF32, pg8::StaticOrder, PG8_ALIGN, PG8_SP2>(F.lds + RING_OFF, g, S, E);
        if (BOTH(5)) GRID_BAR(5);
    }
    if (IN(6)) { final_norm(F); }
#undef IN
#undef BOTH
}

extern "C" void kernel_launch(void* const* d_in, const int* in_sizes, int n_in, void* d_out, int out_size, void* d_ws, size_t ws_size, hipStream_t stream) {
    static int grid = 0;
    if (grid == 0) {
        if (n_in != 20 || in_sizes[0] != M * D || out_size != M * D || ws_size < WS_END) { fprintf(stderr, "kernel_launch: unexpected shapes (n_in %d, in0 %d, out %d, ws %zu); nothing launched\n", n_in, n_in > 0 ? in_sizes[0] : -1, out_size, ws_size); grid = -1; return; }
        int dev = 0, cus = 0, per_cu = 0;
        if (hipGetDevice(&dev) != hipSuccess || hipDeviceGetAttribute(&cus, hipDeviceAttributeMultiprocessorCount, dev) != hipSuccess) { grid = -1; return; }
        if (hipFuncSetAttribute((const void*)hyb_fwd, hipFuncAttributeMaxDynamicSharedMemorySize, LDS_BYTES) != hipSuccess) { fprintf(stderr, "kernel_launch: hipFuncSetAttribute failed\n"); grid = -1; return; }
        if (hipOccupancyMaxActiveBlocksPerMultiprocessor(&per_cu, (const void*)hyb_fwd, NWAVES * 64, LDS_BYTES) != hipSuccess || per_cu < 1)
            fprintf(stderr, "kernel_launch: note: occupancy query reports %d workgroups per CU\n", per_cu);
        (void)hipGetLastError();
        grid = cus;
    }
    if (grid < 0) return;
    if (hipMemsetAsync((char*)d_ws + WS_CTL, 0, CTL_ZERO_BYTES, stream) != hipSuccess) { fprintf(stderr, "kernel_launch: hipMemsetAsync failed\n"); return; }
    Args a{};
    for (int i = 0; i < 20; ++i) a.in[i] = (const float*)d_in[i];
    a.out = (float*)d_out; a.ws = (unsigned char*)d_ws;
    for (int li = 0; li < N_LAUNCHES; ++li) {
        a.ph_lo = (N_LAUNCHES == PER_PHASE) ? li : 0; a.ph_hi = (N_LAUNCHES == PER_PHASE) ? li + 1 : PER_PHASE; a.li = li;
        hipLaunchKernelGGL(hyb_fwd, dim3(grid), dim3(NWAVES * 64), LDS_BYTES, stream, a);
        const hipError_t le = hipPeekAtLastError();
        if (le != hipSuccess) { fprintf(stderr, "kernel_launch: launch %d failed: %s\n", li, hipGetErrorName(le)); break; }
    }
}
```

```cpp
#include <hip/hip_runtime.h>
#include <cstdio>
#include <cstdint>
namespace pg8 {
#define PG8_LAS __attribute__((address_space(3)))
typedef unsigned short bf16_t;
typedef short bf16x8 __attribute__((ext_vector_type(8)));
typedef float f32x4 __attribute__((ext_vector_type(4)));
typedef unsigned u32x4 __attribute__((ext_vector_type(4)));
constexpr int BM = 256, BK = 64, HALF = 128, HTB = HALF * BK * 2  , STAGE_BYTES = 8 * HTB, NXCD = 8, WGM = 8;

__host__ __device__ __forceinline__ int lds_byte(int r, int c) { const int st = (r >> 4) * 2 + (c >> 5), rr = r & 15, cc = c & 31, ob = rr * 64 + cc * 2; return st * 1024 + (ob ^ (((ob >> 9) & 1) << 5)); }
__host__ __device__ __forceinline__ void stage_rc(int b, int& R, int& C) { const int st = b / 1024, sb = b % 1024, swz = sb ^ (((sb >> 9) & 1) << 5); R = (st >> 1) * 16 + swz / 64; C = (st & 1) * 32 + (swz % 64) / 2; }
__host__ __device__ __forceinline__ int perm32(int rho) { const int n = rho >> 4, i = rho & 15; return 8 * (i >> 2) + 4 * n + (i & 3); }

struct Unit { int pm, pn; };
struct Gemm { const bf16_t* A; const bf16_t* Bt; int M, N, K; };

struct StaticOrder {
    int nM, nN, nwg, G, c;
    __host__ __device__ void init(int M, int N, int G_, int c_) { nM = M / BM; nN = N / BM; nwg = nM * nN; G = G_; c = c_; }
    __host__ __device__ bool next(int i, Unit& u) const {
        const long L = (long)i * G + c; if (L >= nwg) return false;
        int wgid = (int)L; { const int q = nwg / NXCD, r = nwg % NXCD, xcd = wgid % NXCD, off = wgid / NXCD; wgid = (xcd < r ? xcd * (q + 1) : r * (q + 1) + (xcd - r) * q) + off; }
        const int nig = WGM * nN, gid = wgid / nig, fm = gid * WGM, gsz = (nM - fm) < WGM ? (nM - fm) : WGM;
        u.pm = fm + ((wgid % nig) % gsz); u.pn = (wgid % nig) / gsz; return true;
    }
    __device__ __forceinline__ void a_ready(const Unit&) const {}
    __device__ __forceinline__ void done(const Unit&) const {}
};

__device__ __forceinline__ unsigned cvt_pk_bf16(float lo, float hi) { unsigned r; asm volatile("v_cvt_pk_bf16_f32 %0, %1, %2" : "=v"(r) : "v"(lo), "v"(hi)); return r; }
template <class Epi, class Sched, bool ALIGN_EPI = false, bool SP2 = false>
__device__ __forceinline__ void gemm_phase(PG8_LAS unsigned char* lds, const Gemm g, const Sched& S, const Epi& E) {
    const int tid = threadIdx.x, wid = __builtin_amdgcn_readfirstlane(tid >> 6), lane = tid & 63, wr = wid >> 2, wc = wid & 3, fr = lane & 15, fq = lane >> 4;
    const int K = g.K, nt = K / BK;
    unsigned voffA[2], voffB[2];
#pragma unroll
    for (int i = 0; i < 2; ++i) { int R, C; stage_rc(tid * 16 + i * 8192, R, C); const int Rb = Epi::PERM ? ((R & ~31) + perm32(R & 31)) : R;
        voffA[i] = (unsigned)(R * K + C) * 2u; voffB[i] = (unsigned)(Rb * K + C) * 2u; }
    const size_t kstep = (size_t)(BK * 2);
    const size_t hstep = (size_t)HALF * K * 2;
    const size_t tstep = 2 * hstep;
    const unsigned ldsw = (unsigned)wid * 1024u;
    const int aoff = lds_byte(wr * 64 + fr, fq * 8), boff = lds_byte(wc * 32 + fr, fq * 8);
#define PG8_SA(b, h) (((b) * 2 + (h)) * HTB)
#define PG8_SB(b, h) ((4 + (b) * 2 + (h)) * HTB)
#define PG8_STAGE(bufoff, gbase, voff) do { _Pragma("unroll") for (int _i = 0; _i < 2; ++_i) \
        __builtin_amdgcn_global_load_lds((const unsigned*)((const char*)(gbase) + (voff)[_i]), (PG8_LAS unsigned*)(lds + (bufoff) + ldsw + _i * 8192), 16, 0, 0); } while (0)
#define PG8_LDA(dst, b, h) do { _Pragma("unroll") for (int m = 0; m < 4; ++m) _Pragma("unroll") for (int k = 0; k < 2; ++k) dst[m][k] = *(const PG8_LAS bf16x8*)(lds + PG8_SA(b, h) + aoff + m * 2048 + k * 1024); } while (0)
#define PG8_LDB(dst, b, h) do { _Pragma("unroll") for (int n = 0; n < 2; ++n) _Pragma("unroll") for (int k = 0; k < 2; ++k) dst[n][k] = *(const PG8_LAS bf16x8*)(lds + PG8_SB(b, h) + boff + n * 2048 + k * 1024); } while (0)
#define PG8_MMA(ai, bj, At, Bt) do { __builtin_amdgcn_s_setprio(1); _Pragma("unroll") for (int m = 0; m < 4; ++m) _Pragma("unroll") for (int n = 0; n < 2; ++n) _Pragma("unroll") for (int k = 0; k < 2; ++k) \
        acc[ai][bj][m][n] = __builtin_amdgcn_mfma_f32_16x16x32_bf16(Bt[n][k], At[m][k], acc[ai][bj][m][n], 0, 0, 0); __builtin_amdgcn_s_setprio(0); } while (0)
#define PG8_WAIT_V(n) asm volatile("s_waitcnt vmcnt(" #n ")" ::: "memory")
#define PG8_WAIT_L(n) asm volatile("s_waitcnt lgkmcnt(" #n ")" ::: "memory")
#define PG8_BAR __builtin_amdgcn_s_barrier()
#define PG8_SCHED __builtin_amdgcn_sched_barrier(0)
    Unit cur, nxt; int ui = 0;
    if (!S.next(0, cur)) return;
    f32x4 acc[2][2][4][2];
#pragma unroll
    for (int a = 0; a < 2; ++a)
#pragma unroll
        for (int b = 0; b < 2; ++b)
#pragma unroll
            for (int m = 0; m < 4; ++m)
#pragma unroll
                for (int n = 0; n < 2; ++n) acc[a][b][m][n] = (f32x4){0.f, 0.f, 0.f, 0.f};
    bf16x8 At[4][2], B0[2][2], B1[2][2];
    const char* cA = (const char*)g.A + (size_t)cur.pm * tstep; const char* cB = (const char*)g.Bt + (size_t)cur.pn * tstep;
    S.a_ready(cur);
    if constexpr (SP2) {
        PG8_STAGE(PG8_SB(0, 0), cB, voffB); PG8_STAGE(PG8_SB(0, 1), cB + hstep, voffB); PG8_STAGE(PG8_SA(0, 0), cA, voffA); PG8_STAGE(PG8_SA(0, 1), cA + hstep, voffA);
        if (wr == 1) PG8_BAR;
        PG8_WAIT_V(2); PG8_BAR;
        PG8_STAGE(PG8_SB(1, 0), cB + kstep, voffB); PG8_STAGE(PG8_SA(1, 0), cA + kstep, voffA); PG8_STAGE(PG8_SB(1, 1), cB + hstep + kstep, voffB);
        PG8_WAIT_V(6); PG8_BAR;
    } else {
        PG8_STAGE(PG8_SB(0, 0), cB, voffB); PG8_STAGE(PG8_SA(0, 0), cA, voffA); PG8_STAGE(PG8_SB(0, 1), cB + hstep, voffB); PG8_STAGE(PG8_SA(0, 1), cA + hstep, voffA);
        if (wr == 1) PG8_BAR;
        PG8_WAIT_V(4); PG8_BAR;
        PG8_STAGE(PG8_SB(1, 0), cB + kstep, voffB); PG8_STAGE(PG8_SA(1, 0), cA + kstep, voffA); PG8_STAGE(PG8_SB(1, 1), cB + hstep + kstep, voffB);
        PG8_WAIT_V(6); PG8_BAR;
    }
    for (;;) {
        const bool has_next = S.next(ui + 1, nxt);
        const char* nA = has_next ? (const char*)g.A + (size_t)nxt.pm * tstep : cA; const char* nB = has_next ? (const char*)g.Bt + (size_t)nxt.pn * tstep : cB;
        for (int t = 0; t < nt; t += 2) {
            const bool last = (t == nt - 2);
            const char* a1 = cA + (size_t)(t + 1) * kstep;
            const char* a2 = last ? nA : cA + (size_t)(t + 2) * kstep; const char* b2 = last ? nB : cB + (size_t)(t + 2) * kstep;
            const char* a3 = a2 + kstep; const char* b3 = b2 + kstep;
            if (last && has_next) S.a_ready(nxt);
            if constexpr (SP2) {
            PG8_LDB(B0, 0, 0); PG8_LDB(B1, 0, 1); PG8_SCHED; PG8_LDA(At, 0, 0); PG8_STAGE(PG8_SA(1, 1), a1 + hstep, voffA);
            PG8_WAIT_V(8); PG8_WAIT_L(0); PG8_BAR; PG8_MMA(0, 0, At, B0); PG8_MMA(0, 1, At, B1); PG8_BAR; PG8_SCHED;
            PG8_LDA(At, 0, 1); PG8_STAGE(PG8_SB(0, 0), b2, voffB); PG8_STAGE(PG8_SB(0, 1), b2 + hstep, voffB); PG8_STAGE(PG8_SA(0, 0), a2, voffA);
            PG8_WAIT_V(8); PG8_WAIT_L(0); PG8_BAR; PG8_MMA(1, 0, At, B0); PG8_MMA(1, 1, At, B1); PG8_BAR; PG8_SCHED;
            PG8_LDB(B0, 1, 0); PG8_LDB(B1, 1, 1); PG8_SCHED; PG8_LDA(At, 1, 0); PG8_STAGE(PG8_SA(0, 1), a2 + hstep, voffA);
            PG8_WAIT_V(8); PG8_WAIT_L(0); PG8_BAR; PG8_MMA(0, 0, At, B0); PG8_MMA(0, 1, At, B1); PG8_BAR; PG8_SCHED;
            PG8_LDA(At, 1, 1); PG8_STAGE(PG8_SB(1, 0), b3, voffB); PG8_STAGE(PG8_SB(1, 1), b3 + hstep, voffB); PG8_STAGE(PG8_SA(1, 0), a3, voffA);
            PG8_WAIT_V(8); PG8_WAIT_L(0); PG8_BAR; PG8_MMA(1, 0, At, B0); PG8_MMA(1, 1, At, B1); PG8_BAR; PG8_SCHED;
            } else {
            PG8_LDB(B0, 0, 0); PG8_SCHED; PG8_LDA(At, 0, 0); PG8_STAGE(PG8_SA(1, 1), a1 + hstep, voffA);
            PG8_WAIT_L(8); PG8_BAR; PG8_WAIT_L(0); PG8_MMA(0, 0, At, B0); PG8_BAR; PG8_SCHED;
            PG8_LDB(B1, 0, 1); PG8_STAGE(PG8_SB(0, 0), b2, voffB);
            PG8_BAR; PG8_WAIT_L(0); PG8_MMA(0, 1, At, B1); PG8_BAR;
            PG8_LDA(At, 0, 1); PG8_STAGE(PG8_SA(0, 0), a2, voffA);
            PG8_BAR; PG8_WAIT_L(0); PG8_MMA(1, 0, At, B0); PG8_BAR; PG8_SCHED;
            PG8_STAGE(PG8_SB(0, 1), b2 + hstep, voffB);
            PG8_WAIT_V(6); PG8_BAR; PG8_MMA(1, 1, At, B1); PG8_BAR;
            PG8_LDB(B0, 1, 0); PG8_SCHED; PG8_LDA(At, 1, 0); PG8_STAGE(PG8_SA(0, 1), a2 + hstep, voffA);
            PG8_WAIT_L(8); PG8_BAR; PG8_WAIT_L(0); PG8_MMA(0, 0, At, B0); PG8_BAR; PG8_SCHED;
            PG8_LDB(B1, 1, 1); PG8_STAGE(PG8_SB(1, 0), b3, voffB);
            PG8_BAR; PG8_WAIT_L(0); PG8_MMA(0, 1, At, B1); PG8_BAR;
            PG8_LDA(At, 1, 1); PG8_STAGE(PG8_SA(1, 0), a3, voffA);
            PG8_BAR; PG8_WAIT_L(0); PG8_MMA(1, 0, At, B0); PG8_BAR; PG8_SCHED;
            PG8_STAGE(PG8_SB(1, 1), b3 + hstep, voffB);
            PG8_WAIT_V(6); PG8_BAR; PG8_MMA(1, 1, At, B1); PG8_BAR;
            }
        }
        if constexpr (ALIGN_EPI) { if (wr == 0) PG8_BAR; }
        if constexpr (!Epi::AFTER_DRAIN) { E(acc, cur, wr, wc, fr, fq); S.done(cur); }
        if (!has_next) break;
#pragma unroll
        for (int a = 0; a < 2; ++a)
#pragma unroll
            for (int b = 0; b < 2; ++b)
#pragma unroll
                for (int m = 0; m < 4; ++m)
#pragma unroll
                    for (int n = 0; n < 2; ++n) acc[a][b][m][n] = (f32x4){0.f, 0.f, 0.f, 0.f};
        cur = nxt; cA = nA; cB = nB; ++ui;
        if constexpr (ALIGN_EPI) { if (wr == 1) PG8_BAR; }
    }
    PG8_WAIT_V(0);
    if constexpr (!ALIGN_EPI) { if (wr == 0) PG8_BAR; }
    PG8_BAR;
    if constexpr (Epi::AFTER_DRAIN) { E.fused(acc, cur, wr, wc, fr, fq, lds, wid, lane); S.done(cur); }
#undef PG8_SA
#undef PG8_SB
#undef PG8_STAGE
#undef PG8_LDA
#undef PG8_LDB
#undef PG8_MMA
#undef PG8_WAIT_V
#undef PG8_WAIT_L
#undef PG8_BAR
#undef PG8_SCHED
}
}
#ifndef PG8_SP2
#define PG8_SP2 true
#endif
#ifndef PG8_ALIGN
#define PG8_ALIGN true
#endif
#include <hip/hip_bf16.h>
#include <cmath>
namespace attn_body {
using bf16=__hip_bfloat16;
using bf16x8=__attribute__((ext_vector_type(8)))short;
using s16x4=__attribute__((ext_vector_type(4)))short;
using f32x16=__attribute__((ext_vector_type(16)))float;
using u32x4=__attribute__((ext_vector_type(4)))unsigned;
constexpr int BATCH=16,NHEAD=8,GQA=4,SEQ=2048,D=64;
constexpr int QP=512,KP=128,GP=512,OP=1024;
constexpr int NW=8,QBLK=32,QB=QBLK*NW,KVBLK=64,NQB=SEQ/QB;
__device__ __forceinline__ int crow(int r,int hi){return (r&3)+8*(r>>2)+4*hi;}
#define SBAR() __builtin_amdgcn_sched_barrier(0)
constexpr int NSLOT=3, SLOTB=8192;
constexpr int LDS_K=0, LDS_V=NSLOT*SLOTB, LDS_WS=2*NSLOT*SLOTB, LDS_OST=LDS_WS+NW*64*4, LDS_BYTES=LDS_OST+NW*4096;
constexpr float C2=0.125f*1.4426950408889634f;
__device__ __forceinline__ void glds16(const void*gsrc,unsigned lds_dst){unsigned keep;
  asm volatile("s_mov_b32 %0, m0\n\ts_mov_b32 m0, %2\n\ts_nop 0\n\tglobal_load_lds_dwordx4 %1, off\n\ts_mov_b32 m0, %0":"=&s"(keep):"v"(gsrc),"s"(lds_dst):"memory");}
__device__ __forceinline__ float max3f(float a,float b,float c){float r;asm("v_max3_f32 %0, %1, %2, %3":"=v"(r):"v"(a),"v"(b),"v"(c));return r;}
__device__ __forceinline__ float max2f(float a,float b){float r;asm("v_max_f32_e32 %0, %1, %2":"=v"(r):"v"(a),"v"(b));return r;}
__device__ __forceinline__ float fadd_s(float a,float b){float r;asm("v_add_f32_e32 %0, %1, %2":"=v"(r):"v"(a),"v"(b));return r;}
__device__ __forceinline__ float fsub_s(float a,float b){float r;asm("v_sub_f32_e32 %0, %1, %2":"=v"(r):"v"(a),"v"(b));return r;}
typedef float f32x2_t __attribute__((ext_vector_type(2))); typedef __bf16 bf16x2_t __attribute__((ext_vector_type(2)));
__device__ __forceinline__ unsigned cvtpk_s(float lo,float hi){f32x2_t v={lo,hi};bf16x2_t b=__builtin_convertvector(v,bf16x2_t);return __builtin_bit_cast(unsigned,b);}
#define WAIT_BAR(N) asm volatile("s_waitcnt vmcnt(" #N ") lgkmcnt(0)\n\ts_barrier":::"memory")

__device__ __forceinline__ void qkt(f32x16&p0,f32x16&p1,const char*Kslot,const bf16x8*qr,const f32x16&negm,int r32,int hi){
  const char*kb=Kslot+hi*1024+r32*16;
  #pragma unroll
  for(int d0=0;d0<4;++d0){
    const bf16x8 b0=*reinterpret_cast<const bf16x8*>(kb+d0*2048);
    const bf16x8 b1=*reinterpret_cast<const bf16x8*>(kb+d0*2048+512);
    if(d0==0){p0=__builtin_amdgcn_mfma_f32_32x32x16_bf16(b0,qr[0],negm,0,0,0);p1=__builtin_amdgcn_mfma_f32_32x32x16_bf16(b1,qr[0],negm,0,0,0);}
    else{p0=__builtin_amdgcn_mfma_f32_32x32x16_bf16(b0,qr[d0],p0,0,0,0);p1=__builtin_amdgcn_mfma_f32_32x32x16_bf16(b1,qr[d0],p1,0,0,0);}}
}
typedef __attribute__((address_space(3))) const char* lds_cptr;
typedef short v4i16_t __attribute__((ext_vector_type(4)));
__device__ __forceinline__ void kload8(bf16x8*kf,lds_cptr kp){
  kf[0]=*(const __attribute__((address_space(3))) bf16x8*)(kp);      kf[1]=*(const __attribute__((address_space(3))) bf16x8*)(kp+512);
  kf[2]=*(const __attribute__((address_space(3))) bf16x8*)(kp+2048); kf[3]=*(const __attribute__((address_space(3))) bf16x8*)(kp+2560);
  kf[4]=*(const __attribute__((address_space(3))) bf16x8*)(kp+4096); kf[5]=*(const __attribute__((address_space(3))) bf16x8*)(kp+4608);
  kf[6]=*(const __attribute__((address_space(3))) bf16x8*)(kp+6144); kf[7]=*(const __attribute__((address_space(3))) bf16x8*)(kp+6656);
}
__device__ __forceinline__ void kload2(bf16x8*kf,lds_cptr kp,int j){ kf[2*j]=*(const __attribute__((address_space(3))) bf16x8*)(kp+j*2048); kf[2*j+1]=*(const __attribute__((address_space(3))) bf16x8*)(kp+j*2048+512); }
__device__ __forceinline__ s16x4 vtr(lds_cptr p){ return __builtin_bit_cast(s16x4,__builtin_amdgcn_ds_read_tr16_b64_v4i16((__attribute__((address_space(3))) v4i16_t*)p)); }
__device__ __forceinline__ float rowmax(const f32x16&p0,const f32x16&p1){
  float a=max3f(p0[0],p0[1],p1[0]),b=max3f(p0[2],p0[3],p1[1]);a=max3f(a,p1[2],p1[3]);
  #pragma unroll
  for(int r=4;r<16;r+=4){a=max3f(a,p0[r],p0[r+1]);b=max3f(b,p0[r+2],p0[r+3]);a=max3f(a,p1[r],p1[r+1]);b=max3f(b,p1[r+2],p1[r+3]);}
  const float m=max2f(a,b);
  auto rr=__builtin_amdgcn_permlane32_swap(__float_as_uint(m),__float_as_uint(m),false,false);
  return max2f(__uint_as_float(rr[0]),__uint_as_float(rr[1]));
}
__device__ __forceinline__ void pv(f32x16*o,int vb,bf16x8 pa0,bf16x8 pa1,bf16x8 pa2,bf16x8 pa3){
  #pragma unroll
  for(int d0=0;d0<2;++d0){s16x4 lo[4],hi[4];
    #pragma unroll
    for(int ks=0;ks<4;++ks){
      asm volatile("ds_read_b64_tr_b16 %0,%1 offset:%c2":"=&v"(lo[ks]):"v"(vb),"i"(d0*4096+ks*1024):"memory");
      asm volatile("ds_read_b64_tr_b16 %0,%1 offset:%c2":"=&v"(hi[ks]):"v"(vb),"i"(d0*4096+ks*1024+512):"memory");}
    asm volatile("s_waitcnt lgkmcnt(0)":::"memory");SBAR();
    #define PK(k) (bf16x8){lo[k][0],lo[k][1],lo[k][2],lo[k][3],hi[k][0],hi[k][1],hi[k][2],hi[k][3]}
    o[d0]=__builtin_amdgcn_mfma_f32_32x32x16_bf16(pa0,PK(0),o[d0],0,0,0);
    o[d0]=__builtin_amdgcn_mfma_f32_32x32x16_bf16(pa1,PK(1),o[d0],0,0,0);
    o[d0]=__builtin_amdgcn_mfma_f32_32x32x16_bf16(pa2,PK(2),o[d0],0,0,0);
    o[d0]=__builtin_amdgcn_mfma_f32_32x32x16_bf16(pa3,PK(3),o[d0],0,0,0);
    #undef PK
  }
}
#ifndef ATTN_STORE16
#define ATTN_STORE16(p,v) (*(u32x4*)(p)=(v))
#endif
template<int THRL> __device__ __forceinline__ void attn_unit(int b,int h,int qb,const bf16*Q,const bf16*__restrict__ K,const bf16*__restrict__ V,const bf16*__restrict__ G,bf16*O,char*shm){
  const int tid=threadIdx.x,lane=tid&63,r32=lane&31,hi=lane>>5; const int wid=__builtin_amdgcn_readfirstlane(tid>>6);
  const long rowbase=(long)b*SEQ; const int q0=qb*QB;
  const bf16*Qw=Q+(rowbase+q0+wid*QBLK)*QP+h*D; const int kvh=h/GQA;
  const bf16*Kh=K+rowbase*KP+kvh*D,*Vh=V+rowbase*KP+kvh*D;
  const unsigned lds0=(unsigned)(uintptr_t)shm;
  float*wsf=(float*)(shm+LDS_WS)+wid*64;
  const bf16*ksrc=Kh+(long)lane*KP+wid*8;
  const bf16*vsrc=Vh+(long)(16*(wid&3)+(lane>>2))*KP+(wid>>2)*32+(lane&3)*8;
  const unsigned kdst=lds0+LDS_K+wid*1024, vdst=lds0+LDS_V+wid*1024;
  #define DMA_K(t,slot) glds16(ksrc+(long)(t)*KVBLK*KP,(unsigned)__builtin_amdgcn_readfirstlane(kdst+(slot)))
  #define DMA_V(t,slot) glds16(vsrc+(long)(t)*KVBLK*KP,(unsigned)__builtin_amdgcn_readfirstlane(vdst+(slot)))
  const int vb0=(int)(lds0+LDS_V)+((lane>>4)&1)*32+(lane&3)*8+(4*hi+((lane&15)>>2))*64;
  const char*Kbase=shm+LDS_K; bf16x8 kf[8];
  const lds_cptr shm3=(lds_cptr)shm; const lds_cptr kp0=shm3+LDS_K+hi*1024+r32*16; const lds_cptr vp0=shm3+LDS_V+((lane>>4)&1)*32+(lane&3)*8+(4*hi+((lane&15)>>2))*64;
  constexpr int NT=SEQ/KVBLK;
  DMA_K(0,0);DMA_V(0,0);DMA_K(1,SLOTB);
  bf16x8 qr[4];
  #pragma unroll
  for(int d0=0;d0<4;++d0)qr[d0]=*reinterpret_cast<const bf16x8*>(&Qw[(long)r32*QP+d0*16+hi*8]);
  float mhat=0.f,l_reg=0.f;f32x16 o[2];o[0]=f32x16{};o[1]=f32x16{};f32x16 negm=f32x16{};asm volatile("":"+v"(negm));
  #define CMASK(P0,P1,t) do{}while(0)
  bool resc=false;
  #define START(P0,P1) do{ const float rm=rowmax(P0,P1); resc=false; \
    { const float dl=rm; mhat=fadd_s(mhat,dl); \
      _Pragma("unroll") for(int r=0;r<16;++r){P0[r]=fsub_s(P0[r],dl);P1[r]=fsub_s(P1[r],dl);} \
      _Pragma("unroll") for(int r=0;r<16;++r)negm[r]=-mhat; asm volatile("":"+v"(negm)); } \
    _Pragma("unroll") for(int r=0;r<16;++r)P0[r]=__builtin_amdgcn_exp2f(P0[r]); }while(0)
  #define RESC() do{ if(resc){ asm volatile("s_waitcnt lgkmcnt(0)":::"memory"); \
      _Pragma("unroll") for(int d_=0;d_<2;++d_) _Pragma("unroll") for(int r=0;r<16;++r)o[d_][r]*=wsf[crow(r,hi)]; } }while(0)
  f32x16 pA0,pA1,pB0,pB1;
  int sl_prev=0,sl_cur=0,sl_next=SLOTB;
  #define ROT() do{sl_prev=sl_cur;sl_cur=sl_next;sl_next=(sl_next==(NSLOT-1)*SLOTB)?0:sl_next+SLOTB;}while(0)
  DMA_K(2,2*SLOTB);
  WAIT_BAR(3);
  qkt(pA0,pA1,Kbase,qr,negm,r32,hi);asm volatile("s_nop 15\n\ts_nop 7":"+v"(pA0),"+v"(pA1));CMASK(pA0,pA1,0);
  START(pA0,pA1);
  _Pragma("unroll") for(int r=0;r<16;++r)pA1[r]=__builtin_amdgcn_exp2f(pA1[r]);
  WAIT_BAR(0);
  DMA_K(3,0);DMA_V(1,SLOTB);
  ROT();
  kload8(kf,kp0+sl_cur);
  WAIT_BAR(2);
  s16x4 vlo[8],vhi[8]; u32x4 pw0,pw1,pw2,pw3;
  #define PKW(P,B) cvtpk_s(P[B],P[B+1])
  #define PAF(k) __builtin_bit_cast(bf16x8,pw##k)
  #define VFR(i) (bf16x8){vlo[i][0],vlo[i][1],vlo[i][2],vlo[i][3],vhi[i][0],vhi[i][1],vhi[i][2],vhi[i][3]}
  #define PIN(x) asm volatile("":"+v"(x))
  #define MX3(a,b,c) __builtin_fmaxf(__builtin_fmaxf((a),(b)),(c))
  #define GAPA(MF,A0,A1,A2,A3,W0,W1,PW) do{ MF; sacc+=A0; sacc+=A1; sacc+=A2; sacc+=A3; PIN(sacc); W0; W1; PIN(PW); SBAR(); }while(0)
  #define EX(v) __builtin_amdgcn_exp2f(v)
  #define GAPB(MF,X,B) do{ MF; X[B]=EX(X[B]); X[B+1]=EX(X[B+1]); X[B+2]=EX(X[B+2]); X[B+3]=EX(X[B+3]); PIN(X); SBAR(); }while(0)
  #define VRD(i) do{ vlo[i]=vtr(vp_+(((i)>>2)*4096+((i)&3)*1024)); vhi[i]=vtr(vp_+(((i)>>2)*4096+((i)&3)*1024+512)); }while(0)
  #define KRD(G,j) do{ if(G){ kload2(kf,kp0+sl_next,j); SBAR(); } }while(0)
  #define STEP(C0,C1,P0,P1,t,GK,GV,GL) do{ SBAR(); \
    const lds_cptr vp_=vp0+sl_prev; \
    VRD(0); SBAR(); float sacc=(P0[0]+P0[1]); \
    GAPA(C0=__builtin_amdgcn_mfma_f32_32x32x16_bf16(kf[0],qr[0],negm,0,0,0), P0[2],P0[3],P0[4],P0[5],     pw0[0]=PKW(P0,0), pw0[1]=PKW(P0,2), pw0); \
    VRD(4); SBAR(); GAPA(C1=__builtin_amdgcn_mfma_f32_32x32x16_bf16(kf[1],qr[0],negm,0,0,0), P0[6],P0[7],P0[8],P0[9],     pw0[2]=PKW(P0,4), pw0[3]=PKW(P0,6), pw0); \
    VRD(1); SBAR(); GAPA(C0=__builtin_amdgcn_mfma_f32_32x32x16_bf16(kf[2],qr[1],C0,0,0,0),   P0[10],P0[11],P0[12],P0[13], pw1[0]=PKW(P0,8), pw1[1]=PKW(P0,10), pw1); \
    VRD(5); SBAR(); GAPA(C1=__builtin_amdgcn_mfma_f32_32x32x16_bf16(kf[3],qr[1],C1,0,0,0),   P0[14],P0[15],P1[0],P1[1],   pw1[2]=PKW(P0,12),pw1[3]=PKW(P0,14), pw1); \
    VRD(2); SBAR(); GAPA(C0=__builtin_amdgcn_mfma_f32_32x32x16_bf16(kf[4],qr[2],C0,0,0,0),   P1[2],P1[3],P1[4],P1[5],     pw2[0]=PKW(P1,0), pw2[1]=PKW(P1,2), pw2); \
    VRD(6); SBAR(); GAPA(C1=__builtin_amdgcn_mfma_f32_32x32x16_bf16(kf[5],qr[2],C1,0,0,0),   P1[6],P1[7],P1[8],P1[9],     pw2[2]=PKW(P1,4), pw2[3]=PKW(P1,6), pw2); \
    VRD(3); SBAR(); GAPA(C0=__builtin_amdgcn_mfma_f32_32x32x16_bf16(kf[6],qr[3],C0,0,0,0),   P1[10],P1[11],P1[12],P1[13], pw3[0]=PKW(P1,8), pw3[1]=PKW(P1,10), pw3); \
    VRD(7); SBAR(); GAPA(C1=__builtin_amdgcn_mfma_f32_32x32x16_bf16(kf[7],qr[3],C1,0,0,0),   P1[14],P1[15],0.f,0.f,       pw3[2]=PKW(P1,12),pw3[3]=PKW(P1,14), pw3); \
    l_reg+=sacc; \
    if(GK){DMA_K((t)+3,sl_cur);} if(GV){DMA_V((t)+1,sl_next);} \
    CMASK(C0,C1,t); \
    { float a=MX3(C0[0],C0[1],C1[0]),b=MX3(C0[2],C0[3],C1[1]); a=MX3(a,C1[2],C1[3]); \
      _Pragma("unroll") for(int r=4;r<16;r+=4){a=MX3(a,C0[r],C0[r+1]);b=MX3(b,C0[r+2],C0[r+3]);a=MX3(a,C1[r],C1[r+1]);b=MX3(b,C1[r+2],C1[r+3]);} \
      float rm=__builtin_fmaxf(a,b); { auto rr=__builtin_amdgcn_permlane32_swap(__float_as_uint(rm),__float_as_uint(rm),false,false); rm=__builtin_fmaxf(__uint_as_float(rr[0]),__uint_as_float(rr[1])); } \
      resc=false; \
      if(__builtin_expect(__any(rm>(float)THRL),0)){ const float dl=__builtin_fmaxf(rm,0.f); mhat+=dl; \
        _Pragma("unroll") for(int r=0;r<16;++r){C0[r]-=dl;C1[r]-=dl;} \
        _Pragma("unroll") for(int r=0;r<16;++r)negm[r]=-mhat; asm volatile("":"+v"(negm)); \
        const float f=__builtin_amdgcn_exp2f(-dl); l_reg*=f; if(hi==0)wsf[r32]=f; resc=true; } } \
    SBAR(); \
    GAPB(o[0]=__builtin_amdgcn_mfma_f32_32x32x16_bf16(PAF(0),VFR(0),o[0],0,0,0), C0,0); \
    GAPB(o[1]=__builtin_amdgcn_mfma_f32_32x32x16_bf16(PAF(0),VFR(4),o[1],0,0,0), C0,4); \
    KRD(GL,0); GAPB(o[0]=__builtin_amdgcn_mfma_f32_32x32x16_bf16(PAF(1),VFR(1),o[0],0,0,0), C0,8); \
    KRD(GL,1); GAPB(o[1]=__builtin_amdgcn_mfma_f32_32x32x16_bf16(PAF(1),VFR(5),o[1],0,0,0), C0,12); \
    KRD(GL,2); GAPB(o[0]=__builtin_amdgcn_mfma_f32_32x32x16_bf16(PAF(2),VFR(2),o[0],0,0,0), C1,0); \
    KRD(GL,3); GAPB(o[1]=__builtin_amdgcn_mfma_f32_32x32x16_bf16(PAF(2),VFR(6),o[1],0,0,0), C1,4); \
    GAPB(o[0]=__builtin_amdgcn_mfma_f32_32x32x16_bf16(PAF(3),VFR(3),o[0],0,0,0), C1,8); \
    GAPB(o[1]=__builtin_amdgcn_mfma_f32_32x32x16_bf16(PAF(3),VFR(7),o[1],0,0,0), C1,12); \
    }while(0)
  int t=1;
  #undef CMASK
  #define CMASK(P0,P1,t) do{}while(0)
  for(;t+5<NT;t+=2){
    STEP(pB0,pB1,pA0,pA1,t,true,true,true);     WAIT_BAR(2); RESC(); ROT();
    STEP(pA0,pA1,pB0,pB1,t+1,true,true,true);   WAIT_BAR(2); RESC(); ROT();
  }
  #undef CMASK
  #define CMASK(P0,P1,t) do{}while(0)
  #define ENDW(tt) do{ if((tt)+3<NT){WAIT_BAR(2);} else if((tt)+2<NT){WAIT_BAR(1);} else {WAIT_BAR(0);} }while(0)
  for(;t+1<NT;t+=2){
    STEP(pB0,pB1,pA0,pA1,t,(t+3<NT),(t+1<NT),(t+1<NT));       ENDW(t);   RESC(); ROT();
    STEP(pA0,pA1,pB0,pB1,t+1,(t+4<NT),(t+2<NT),(t+2<NT));     ENDW(t+1); RESC(); ROT();
  }
  STEP(pB0,pB1,pA0,pA1,NT-1,false,false,false); RESC();
  { float sacc=pB0[0]+pB0[1]; _Pragma("unroll") for(int r=2;r<16;++r)sacc+=pB0[r]; _Pragma("unroll") for(int r=0;r<16;++r)sacc+=pB1[r]; l_reg+=sacc;
    pw0=(u32x4){PKW(pB0,0),PKW(pB0,2),PKW(pB0,4),PKW(pB0,6)};pw1=(u32x4){PKW(pB0,8),PKW(pB0,10),PKW(pB0,12),PKW(pB0,14)};pw2=(u32x4){PKW(pB1,0),PKW(pB1,2),PKW(pB1,4),PKW(pB1,6)};pw3=(u32x4){PKW(pB1,8),PKW(pB1,10),PKW(pB1,12),PKW(pB1,14)};
    SBAR(); pv(o,vb0+sl_cur,PAF(0),PAF(1),PAF(2),PAF(3)); }
  #undef PKW
  #undef PAF
  #undef VFR
  #undef PIN
  #undef MX3
  #undef GAPA
  #undef GAPB
  #undef EX
  #undef VRD
  #undef KRD
  #undef STEP
  #undef ENDW
  {auto rr=__builtin_amdgcn_permlane32_swap(__float_as_uint(l_reg),__float_as_uint(l_reg),false,false);l_reg=__uint_as_float(rr[0])+__uint_as_float(rr[1]);}
  if(hi==0)wsf[32+r32]=l_reg;asm volatile("s_waitcnt lgkmcnt(0)":::"memory");
  float rli[16];
  #pragma unroll
  for(int r=0;r<16;++r)rli[r]=__builtin_amdgcn_rcpf(wsf[32+crow(r,hi)]);
  bf16*Ow=O+(rowbase+q0+wid*QBLK)*OP+h*D; const bf16*Gw=G+(rowbase+q0+wid*QBLK)*GP+h*D;
  { bf16*stg=(bf16*)(shm+LDS_OST)+wid*2048;
    #pragma unroll
    for(int r=0;r<16;++r){const int orow=crow(r,hi);
      #pragma unroll
      for(int d0=0;d0<2;++d0)stg[orow*64+d0*32+r32]=__float2bfloat16(o[d0][r]*rli[r]);}
    asm volatile("s_waitcnt lgkmcnt(0)":::"memory");
    #pragma unroll
    for(int i=0;i<4;++i){const int row=i*8+(lane>>3),ch=lane&7; const u32x4 v=*(const u32x4*)(stg+row*64+ch*8); const u32x4 g=*(const u32x4*)(Gw+(long)row*GP+ch*8); u32x4 w;
      #pragma unroll
      for(int e=0;e<4;++e){ const float a0=__uint_as_float(v[e]<<16)*__uint_as_float(g[e]<<16), a1=__uint_as_float(v[e]&0xffff0000u)*__uint_as_float(g[e]&0xffff0000u); w[e]=cvtpk_s(a0,a1);}
      ATTN_STORE16(Ow+(long)row*OP+ch*8,w);} }
  asm volatile("s_waitcnt lgkmcnt(0)\n\ts_barrier":::"memory");
  #undef DMA_K
  #undef DMA_V
  #undef CMASK
  #undef START
  #undef RESC
  #undef ROT
}
constexpr int ATTN_LDS_BYTES=LDS_BYTES;
struct AttnTensors { const bf16* Q; const bf16* K; const bf16* V; const bf16* G; bf16* O; };
struct AttnUnit { int bh; int qb; };
struct StaticOrder {
  int vcu, upc;
  __device__ __forceinline__ explicit StaticOrder(int grid,int block):vcu((grid%8==0)?(block%8)*(grid/8)+block/8:block),upc((BATCH*NHEAD*NQB+grid-1)/grid){}
  __device__ __forceinline__ bool next(int i,AttnUnit&u)const{ if(i>=upc)return false; const int x=vcu*upc+i; if(x>=BATCH*NHEAD*NQB)return false; u.qb=x%NQB; u.bh=x/NQB; return true; }
  __device__ __forceinline__ void a_ready(const AttnUnit&)const{}
  __device__ __forceinline__ void done(const AttnUnit&)const{}
};
template<class Sched,int THRL=8> __device__ __forceinline__ void attn_phase(char*lds,const AttnTensors&T,const Sched&S){
  AttnUnit u;
  for(int i=0;S.next(i,u);++i){ S.a_ready(u); attn_unit<THRL>(u.bh/NHEAD,u.bh%NHEAD,u.qb,T.Q,T.K,T.V,T.G,T.O,lds); S.done(u); }
}
#undef SBAR
#undef WAIT_BAR
}
constexpr int NWAVES = 8;
#ifndef MK_N_LAUNCHES
#define MK_N_LAUNCHES 1
#endif
constexpr int PER_PHASE = 7;
constexpr int N_LAUNCHES = MK_N_LAUNCHES;
static_assert(N_LAUNCHES == 1 || N_LAUNCHES == PER_PHASE, "MK_N_LAUNCHES is 1 or 7");

constexpr int BATCH = 16, T = 2048, D = 1024, HD = 64;
constexpr int M = BATCH * T;
constexpr int NIN = 3456, NINP = 3584;
constexpr int RW = 512, RSW = 1664;
constexpr float NORM_EPS = 1e-6f, GN_EPS = 64e-5f, L2_EPS = 1e-12f, DECAY_SCALE = 0.6065306597126334f;

constexpr size_t MiB = 1u << 20;
constexpr size_t WS_CTL = 0, CTL_ZERO_BYTES = 1 * MiB;
constexpr size_t WS_MOD = 512 * 1024;
constexpr size_t WS_ROPE = 1 * MiB;
constexpr size_t WS_WIN = 2 * MiB;
constexpr size_t WS_WOUT = 10 * MiB;
constexpr size_t WS_XCH = 12 * MiB;
constexpr size_t WS_BON = 14 * MiB;
constexpr size_t WS_XN = 16 * MiB;
constexpr size_t WS_Q = 80 * MiB, WS_K = 112 * MiB, WS_V = 120 * MiB;
constexpr size_t WS_GATT = 128 * MiB;
constexpr size_t WS_RKV = 160 * MiB;
constexpr size_t WS_WA = 256 * MiB;
constexpr size_t WS_GRW = 264 * MiB;
constexpr size_t WS_Y = 296 * MiB;
constexpr size_t WS_OUTPRE = 80 * MiB;
constexpr size_t WS_END = 424 * MiB;
constexpr int CW_TMO = 0, CW_CODE = 1;
constexpr int CW_BAR = 4096;
constexpr int CW_SEAM = 16384;

constexpr int RING_OFF = 0, RING_BYTES = 143360;
constexpr int LDSCTL_OFF = RING_BYTES, MISC_OFF = LDSCTL_OFF + 320;
constexpr int LDS_BYTES = 147456;
static_assert(MISC_OFF + 128 <= LDS_BYTES, "LDS map");
#define GAS __attribute__((address_space(1)))
#define LAS __attribute__((address_space(3)))
typedef unsigned short bf16;
typedef unsigned v4u __attribute__((ext_vector_type(4)));
typedef float f32x4 __attribute__((ext_vector_type(4)));
typedef short bf16x8 __attribute__((ext_vector_type(8)));
typedef GAS unsigned gu32;
typedef GAS unsigned long long gu64;
#define RLX_AGENT __ATOMIC_RELAXED, __HIP_MEMORY_SCOPE_AGENT
#define LDS_WAIT() asm volatile("s_waitcnt lgkmcnt(0)" ::: "memory")
#define VM_WAIT() asm volatile("s_waitcnt vmcnt(0)" ::: "memory")
__device__ __forceinline__ unsigned long long rt() { return __builtin_amdgcn_s_memrealtime(); }
__device__ __forceinline__ unsigned f2bf(float f) { unsigned u = __builtin_bit_cast(unsigned, f); return (u + 0x7fffu + ((u >> 16) & 1u)) >> 16; }
__device__ __forceinline__ unsigned pk2(float lo, float hi) { return f2bf(lo) | (f2bf(hi) << 16); }

#define XB_TMO      128
#define XB_XCNT(j)  (256  + 64 * (j))
#define XB_XSUB(j)  (1280 + 64 * (j))
#define XB_XGEN(j)  (2304 + 64 * (j))
#define XB_TOP      3328
#define XB_TOPGEN   3392
#define XCD_BAR_WORDS 3456
#define XB_SPIN_CAP (1u << 18)

__device__ __forceinline__ unsigned xb_ld(unsigned* p)              { return __hip_atomic_load(p, __ATOMIC_RELAXED, __HIP_MEMORY_SCOPE_AGENT); }
__device__ __forceinline__ unsigned xb_add(unsigned* p, unsigned v) { return __hip_atomic_fetch_add(p, v, __ATOMIC_RELAXED, __HIP_MEMORY_SCOPE_AGENT); }
__device__ __forceinline__ unsigned xb_xcc_id() { return (unsigned)__builtin_amdgcn_s_getreg((3 << 11) | 20) & 0xFu; }
#define XB_SPIN(cond, bar) do { unsigned _sp = 0; while (cond) { __builtin_amdgcn_s_sleep(1); \
    if ((++_sp & 255u) == 0u) { if (xb_ld(&(bar)[XB_TMO])) break; if (_sp > XB_SPIN_CAP) { atomicAdd(&(bar)[XB_TMO], 1u); break; } } } } while (0)

struct XcdBarrier {
    unsigned* bar; unsigned x;
    volatile LAS unsigned* st;
};

__device__ __forceinline__ XcdBarrier xcd_barrier_post(unsigned* bar, volatile LAS unsigned* st) {
    XcdBarrier b; b.bar = bar; b.x = xb_xcc_id(); b.st = st;
    if (threadIdx.x == 0) (void)xb_add(&bar[XB_XCNT(b.x)], 1u);
    return b;
}
__device__ __forceinline__ void xcd_barrier_complete(unsigned* bar, unsigned x, unsigned& nloc, unsigned& nx) {
    const unsigned G = gridDim.x * gridDim.y * gridDim.z;
    unsigned sum, cnt, mine, sp = 0u;
    for (;;) {
        sum = 0u; cnt = 0u; mine = 0u;
#pragma unroll
        for (unsigned j = 0; j < 16; ++j) { const unsigned c = xb_ld(&bar[XB_XCNT(j)]); sum += c; cnt += (c > 0u) ? 1u : 0u; mine = (j == x) ? c : mine; }
        if (sum == G) break;
        __builtin_amdgcn_s_sleep(1);
        if ((++sp & 255u) == 0u) { if (xb_ld(&bar[XB_TMO])) break; if (sp > XB_SPIN_CAP) { atomicAdd(&bar[XB_TMO], 1u); break; } }
    }
    nloc = mine > 0u ? mine : 1u; nx = cnt > 0u ? cnt : 1u;
}

__device__ __forceinline__ void xcd_barrier(const XcdBarrier& b) {
    asm volatile("s_waitcnt vmcnt(0)" ::: "memory");
    __syncthreads();
    if (threadIdx.x == 0) {
        unsigned* bar = b.bar;
        __builtin_amdgcn_s_waitcnt(0);
        unsigned nloc = b.st[0], nx = b.st[1];
        if (nloc == 0u) { xcd_barrier_complete(bar, b.x, nloc, nx); b.st[0] = nloc; b.st[1] = nx; }
        const unsigned old = xb_add(&bar[XB_XSUB(b.x)], 1u);
        const unsigned gen = old / nloc;
        if (old + 1u == (gen + 1u) * nloc) {
            __builtin_amdgcn_fence(__ATOMIC_RELEASE, "agent");
            asm volatile("s_waitcnt vmcnt(0)" ::: "memory");
            const unsigned og = xb_add(&bar[XB_TOP], 1u);
            const unsigned tg = og / nx;
            if (og + 1u == (tg + 1u) * nx) xb_add(&bar[XB_TOPGEN], 1u);
            else XB_SPIN(xb_ld(&bar[XB_TOPGEN]) == tg, bar);
            __builtin_amdgcn_fence(__ATOMIC_ACQUIRE, "agent");
            xb_add(&bar[XB_XGEN(b.x)], 1u);
            asm volatile("s_waitcnt vmcnt(0)" ::: "memory");
        } else {
            XB_SPIN(xb_ld(&bar[XB_XGEN(b.x)]) == gen, bar);
            __builtin_amdgcn_fence(__ATOMIC_ACQUIRE, "agent");
            asm volatile("s_waitcnt vmcnt(0)" ::: "memory");
        }
    }
    __syncthreads();
}
#define CAS __attribute__((address_space(4)))
struct Frame {
    LAS unsigned char* lds;
    volatile LAS unsigned* MISC;
    gu32* ctl;
    int tid, lane, wave;
    int vcu, G;
    const CAS char* kp;
};
struct Ptrs {
    const float *x, *c, *w_ada, *b_ada, *g_pre, *w_in, *q_norm_g, *k_norm_g, *taps, *w_up, *w0, *a_up, *a0, *k_k, *k_a, *r_k, *gn_w, *gn_b, *w_out, *g_post;
    float* out;
    float *MOD, *ROPE, *BON, *Y, *OUTPRE;
    bf16 *Win_t, *Wout_t, *XN, *QB, *KB, *VB, *GATT, *RKV, *WA, *GRW, *MIX;
};
__device__ __forceinline__ Ptrs load_ptrs(const Frame& F) {
    const CAS char* kp = F.kp; asm volatile("" : "+s"(kp));
    const float* const CAS* in = (const float* const CAS*)kp;
    Ptrs P;
    P.x = in[0]; P.c = in[1]; P.w_ada = in[2]; P.b_ada = in[3]; P.g_pre = in[4]; P.w_in = in[5]; P.q_norm_g = in[6]; P.k_norm_g = in[7];
    P.taps = in[8]; P.w_up = in[9]; P.w0 = in[10]; P.a_up = in[11]; P.a0 = in[12]; P.k_k = in[13]; P.k_a = in[14]; P.r_k = in[15];
    P.gn_w = in[16]; P.gn_b = in[17]; P.w_out = in[18]; P.g_post = in[19];
    P.out = *(float* const CAS*)(kp + 160); unsigned char* ws = *(unsigned char* const CAS*)(kp + 168);
    P.MOD = (float*)(ws + WS_MOD); P.ROPE = (float*)(ws + WS_ROPE); P.BON = (float*)(ws + WS_BON); P.Y = (float*)(ws + WS_Y); P.OUTPRE = (float*)(ws + WS_OUTPRE);
    P.Win_t = (bf16*)(ws + WS_WIN); P.Wout_t = (bf16*)(ws + WS_WOUT); P.XN = (bf16*)(ws + WS_XN); P.MIX = (bf16*)(ws + WS_XN);
    P.QB = (bf16*)(ws + WS_Q); P.KB = (bf16*)(ws + WS_K); P.VB = (bf16*)(ws + WS_V); P.GATT = (bf16*)(ws + WS_GATT); P.RKV = (bf16*)(ws + WS_RKV); P.WA = (bf16*)(ws + WS_WA); P.GRW = (bf16*)(ws + WS_GRW);
    return P;
}

__device__ __forceinline__ float wave_sum(float v) {
#pragma unroll
    for (int o = 1; o < 64; o <<= 1) v += __shfl_xor(v, o);
    return v;
}
__device__ __forceinline__ float bf2f(bf16 v) { return __uint_as_float((unsigned)v << 16); }
__device__ __forceinline__ float sigmoidf_(float v) { return 1.0f / (1.0f + __expf(-v)); }
__device__ __forceinline__ float siluf_(float v) { return v / (1.0f + __expf(-v)); }

__device__ __forceinline__ int win_dest_row(int n) {
    if (n < 640) {
        const int hd = n >> 6, d = n & 63, tile = hd >> 2, wc = hd & 3, bj = d >> 5, dl = d & 31, nn = dl >> 4, fq = (dl >> 2) & 3, e = dl & 3;
        return tile * 256 + 128 * bj + 32 * wc + 8 * fq + 4 * nn + e;
    }
    if (n < 768) { const int j = n - 640, vh = j >> 6, d = j & 63; return 2 * 256 + 128 * (d >> 5) + 32 * (2 + vh) + (d & 31); }
    if (n < 1280) return 3 * 256 + (n - 768);
    if (n < 2816) return 5 * 256 + (n - 1280);
    if (n < 2944) return 11 * 256 + (n - 2816);
    return 12 * 256 + (n - 2944);
}
template <bool PERMUTE>
__device__ __forceinline__ void p0_transpose_item(const float* W, int K, int N, bf16* WT, LAS float* scr, int item, int lane) {
    const int nblk = N / 32, kb = item / nblk, nb = item % nblk, k0 = 64 * kb, n0 = 32 * nb;
#pragma unroll 8
    for (int i = 0; i < 32; ++i) { const int kk = 2 * i + (lane >> 5); scr[kk * 33 + (lane & 31)] = W[(size_t)(k0 + kk) * N + n0 + (lane & 31)]; }
    LDS_WAIT(); asm volatile("" ::: "memory");
    const int c = lane & 7;
#pragma unroll
    for (int j = 0; j < 4; ++j) { const int n = (lane >> 3) + 8 * j; const LAS float* s = scr + (8 * c) * 33 + n;
        v4u o; o.x = pk2(s[0 * 33], s[1 * 33]); o.y = pk2(s[2 * 33], s[3 * 33]); o.z = pk2(s[4 * 33], s[5 * 33]); o.w = pk2(s[6 * 33], s[7 * 33]);
        const int drow = PERMUTE ? win_dest_row(n0 + n) : (n0 + n);
        *(GAS v4u*)(WT + (size_t)drow * K + k0 + 8 * c) = o; }
    LDS_WAIT(); asm volatile("" ::: "memory");
}
__device__ __forceinline__ void p0_mod_item(Frame& F, const Ptrs& P, LAS float* scr, int item) {
    const int cb = item >> 3, ks = item & 7, col = cb * 64 + F.lane, k0 = ks * 128;
    for (int i = F.lane; i < 16 * 128; i += 64) { const int b = i >> 7, k = i & 127; scr[i] = siluf_(P.c[b * D + k0 + k]); }
    LDS_WAIT(); asm volatile("" ::: "memory");
    float acc[16];
#pragma unroll
    for (int b = 0; b < 16; ++b) acc[b] = 0.f;
    for (int k = 0; k < 128; k += 4) {
        float w[4];
#pragma unroll
        for (int j = 0; j < 4; ++j) w[j] = P.w_ada[(size_t)(k0 + k + j) * (3 * D) + col];
#pragma unroll
        for (int b = 0; b < 16; ++b) { const f32x4 s = *(const LAS f32x4*)(scr + b * 128 + k); acc[b] += s[0] * w[0] + s[1] * w[1] + s[2] * w[2] + s[3] * w[3]; }
    }
    const float bias = (ks == 0) ? P.b_ada[col] : 0.f;
#pragma unroll
    for (int b = 0; b < 16; ++b) atomicAdd(P.MOD + b * (3 * D) + col, acc[b] + bias);
    LDS_WAIT(); asm volatile("" ::: "memory");
}
__device__ __forceinline__ void p0_prologue(Frame& F) {
    const Ptrs P = load_ptrs(F);
    LAS float* scr = (LAS float*)(F.lds + RING_OFF + F.wave * 16384);
    const int gw = F.vcu * NWAVES + F.wave, NGW = F.G * NWAVES;
    constexpr int I_IN = (D / 64) * (NIN / 32), I_OUT = (D / 64) * (D / 32), I_MOD = 48 * 8;
    constexpr int NITEMS = I_IN + I_OUT + I_MOD;
    for (int it0 = gw; it0 < NITEMS; it0 += NGW) {
        int r = NITEMS - 1 - it0;
        if (r >= I_IN + I_OUT) { p0_mod_item(F, P, scr, r - I_IN - I_OUT); continue; }
        if (r < I_IN) { p0_transpose_item<true>(P.w_in, D, NIN, P.Win_t, scr, r, F.lane); continue; } r -= I_IN;
        p0_transpose_item<false>(P.w_out, D, D, P.Wout_t, scr, r, F.lane);
    }
    { const int gt = F.vcu * (NWAVES * 64) + F.tid, NGT = F.G * NWAVES * 64;
      for (int i = gt; i < 16384; i += NGT) *(GAS v4u*)(P.Win_t + (size_t)(11 * 256 + 128) * D + (size_t)i * 8) = (v4u){0u, 0u, 0u, 0u};
      for (int i = gt; i < 1024; i += NGT) { const int pos = i >> 4, fi = i & 15; const float inv = powf(10000.0f, -(float)fi / 16.0f); const float ang = (float)pos * inv;
          P.ROPE[i] = cosf(ang); P.ROPE[1024 + i] = sinf(ang); } }
}
__device__ __forceinline__ void p1_xn(Frame& F) {
    const Ptrs P = load_ptrs(F);
    const int gw = F.vcu * NWAVES + F.wave, NGW = F.G * NWAVES;
    for (int grp = gw; grp < M / 16; grp += NGW) {
        const int m0 = grp * 16, b = m0 / T;
        f32x4 gs[4], sh[4];
#pragma unroll
        for (int j = 0; j < 4; ++j) { const int d0 = 256 * j + 4 * F.lane; const f32x4 g = *(const GAS f32x4*)(P.g_pre + d0), sc = *(const GAS f32x4*)(P.MOD + b * 3 * D + D + d0);
            gs[j] = g * (sc + 1.0f); sh[j] = *(const GAS f32x4*)(P.MOD + b * 3 * D + d0); }
        for (int r = 0; r < 16; ++r) {
            const GAS f32x4* xr = (const GAS f32x4*)(P.x + (size_t)(m0 + r) * D) + F.lane;
            f32x4 v[4]; float s = 0.f;
#pragma unroll
            for (int j = 0; j < 4; ++j) { v[j] = xr[64 * j]; s += (v[j].x * v[j].x + v[j].y * v[j].y) + (v[j].z * v[j].z + v[j].w * v[j].w); }
            const float rstd = 1.f / sqrtf(wave_sum(s) * (1.f / D) + NORM_EPS);
            GAS unsigned long long* o8 = (GAS unsigned long long*)(P.XN + (size_t)(m0 + r) * D) + F.lane;
#pragma unroll
            for (int j = 0; j < 4; ++j) { const f32x4 h = v[j] * rstd * gs[j] + sh[j];
                o8[64 * j] = (unsigned long long)pk2(h.x, h.y) | ((unsigned long long)pk2(h.z, h.w) << 32); }
        }
    }
}

struct EpiInProj {
    static constexpr bool PERM = true, AFTER_DRAIN = false;
    bf16 *Q, *K, *V, *GATT, *RKV, *WA, *GRW; const float *qg, *kg, *rope; float c2;
    __device__ __forceinline__ void operator()(const f32x4 (&acc)[2][2][4][2], const pg8::Unit& u, int wr, int wc, int fr, int fq) const {
        const int pn = u.pn, row0 = u.pm * 256 + wr * 64 + fr;
        if (pn >= 3) {
            bf16* base; int ldc, colt; bool act;
            if (pn < 5) { base = GATT; ldc = 512; colt = (pn - 3) * 256; act = true; }
            else if (pn < 11) { base = RKV; ldc = 1536; colt = (pn - 5) * 256; act = false; }
            else if (pn == 11) { base = WA; ldc = 128; colt = 0; act = false; }
            else { base = GRW; ldc = 512; colt = (pn - 12) * 256; act = true; }
            const int col0 = colt + wc * 32 + 8 * fq;
#pragma unroll
            for (int ai = 0; ai < 2; ++ai)
#pragma unroll
                for (int m = 0; m < 4; ++m) { bf16* rowp = base + (size_t)(row0 + ai * 128 + m * 16) * ldc + col0;
#pragma unroll
                    for (int bj = 0; bj < 2; ++bj) { if (pn == 11 && bj == 1) continue;
                        f32x4 v0 = acc[ai][bj][m][0], v1 = acc[ai][bj][m][1];
                        if (act) { v0 = (f32x4){siluf_(v0[0]), siluf_(v0[1]), siluf_(v0[2]), siluf_(v0[3])}; v1 = (f32x4){siluf_(v1[0]), siluf_(v1[1]), siluf_(v1[2]), siluf_(v1[3])}; }
                        v4u w; w.x = pg8::cvt_pk_bf16(v0[0], v0[1]); w.y = pg8::cvt_pk_bf16(v0[2], v0[3]); w.z = pg8::cvt_pk_bf16(v1[0], v1[1]); w.w = pg8::cvt_pk_bf16(v1[2], v1[3]);
                        *(v4u*)(rowp + bj * 128) = w; } }
        } else if (pn == 2 && wc >= 2) {
#pragma unroll
            for (int ai = 0; ai < 2; ++ai)
#pragma unroll
                for (int m = 0; m < 4; ++m) { bf16* rowp = V + (size_t)(row0 + ai * 128 + m * 16) * 128 + (wc - 2) * 64 + 8 * fq;
#pragma unroll
                    for (int bj = 0; bj < 2; ++bj) { const f32x4 v0 = acc[ai][bj][m][0], v1 = acc[ai][bj][m][1];
                        v4u w; w.x = pg8::cvt_pk_bf16(v0[0], v0[1]); w.y = pg8::cvt_pk_bf16(v0[2], v0[3]); w.z = pg8::cvt_pk_bf16(v1[0], v1[1]); w.w = pg8::cvt_pk_bf16(v1[2], v1[3]);
                        *(v4u*)(rowp + bj * 32) = w; } }
        } else {
            const bool isq = pn < 2; const float* g = isq ? qg : kg; const float sc = isq ? c2 : 1.0f;
            bf16* base = isq ? (Q + (pn * 4 + wc) * 64) : (K + wc * 64); const int ldc = isq ? 512 : 128;
            f32x4 gv[2][2];
#pragma unroll
            for (int bj = 0; bj < 2; ++bj)
#pragma unroll
                for (int n = 0; n < 2; ++n) gv[bj][n] = *(const f32x4*)(g + 32 * bj + 16 * n + 4 * fq);
#pragma unroll
            for (int ai = 0; ai < 2; ++ai)
#pragma unroll
                for (int m = 0; m < 4; ++m) { const int row = row0 + ai * 128 + m * 16, t = row & (T - 1);
                    float ss = 0.f;
#pragma unroll
                    for (int bj = 0; bj < 2; ++bj)
#pragma unroll
                        for (int n = 0; n < 2; ++n) { const f32x4 v = acc[ai][bj][m][n]; ss += (v[0] * v[0] + v[1] * v[1]) + (v[2] * v[2] + v[3] * v[3]); }
                    ss += __shfl_xor(ss, 16); ss += __shfl_xor(ss, 32);
                    const float rstd = sc / sqrtf(ss * (1.0f / 64.0f) + NORM_EPS);
#pragma unroll
                    for (int bj = 0; bj < 2; ++bj) { const int pos = bj ? (t & 63) : (t >> 6);
                        const f32x4 cs = *(const f32x4*)(rope + pos * 16 + 4 * fq), sn = *(const f32x4*)(rope + 1024 + pos * 16 + 4 * fq);
                        const f32x4 x1 = acc[ai][bj][m][0] * rstd * gv[bj][0], x2 = acc[ai][bj][m][1] * rstd * gv[bj][1];
                        const f32x4 y1 = x1 * cs - x2 * sn, y2 = x2 * cs + x1 * sn;
                        v4u w; w.x = pg8::cvt_pk_bf16(y1[0], y1[1]); w.y = pg8::cvt_pk_bf16(y1[2], y1[3]); w.z = pg8::cvt_pk_bf16(y2[0], y2[1]); w.w = pg8::cvt_pk_bf16(y2[2], y2[3]);
                        *(v4u*)(base + (size_t)row * ldc + 32 * bj + 8 * fq) = w; } }
        }
    }
};
struct EpiF32 {
    static constexpr bool PERM = false, AFTER_DRAIN = false;
    float* O; int ldc;
    __device__ __forceinline__ void operator()(const f32x4 (&acc)[2][2][4][2], const pg8::Unit& u, int wr, int wc, int fr, int fq) const {
        const int row0 = u.pm * 256 + wr * 64 + fr, col0 = u.pn * 256 + wc * 32 + 4 * fq;
#pragma unroll
        for (int ai = 0; ai < 2; ++ai)
#pragma unroll
            for (int m = 0; m < 4; ++m) { float* rowp = O + (size_t)(row0 + ai * 128 + m * 16) * ldc + col0;
#pragma unroll
                for (int bj = 0; bj < 2; ++bj)
#pragma unroll
                    for (int n = 0; n < 2; ++n) *(f32x4*)(rowp + bj * 128 + n * 16) = acc[ai][bj][m][n]; }
    }
};

constexpr int TC = 32;
__device__ __forceinline__ void rwkv_scan_seq(Frame& F, int unit) {
    const Ptrs P = load_ptrs(F);
    const int z = unit >> 7, b = (unit >> 3) & 15, h = unit & 7, tid = F.tid, lane = F.lane;
    LAS float* L = (LAS float*)(F.lds + RING_OFF);
    LAS float* WUP = L;              LAS float* AUP = L + 4096;
    LAS float* RR = L + 8192;        LAS float* KR = RR + 2048;  LAS float* VV = KR + 2048;  LAS float* WD = VV + 2048;  LAS float* AD = WD + 2048;
    LAS float* WW = AD + 2048;       LAS float* KK = WW + 2048;  LAS float* AKK = KK + 2048; LAS float* KT = AKK + 2048;
    LAS float* YO = KT + 2048;       LAS float* BO = YO + 2048;
    for (int i = tid; i < 4096; i += 512) { const int r = i >> 6, c = i & 63; WUP[i] = P.w_up[(size_t)(z * 64 + r) * RW + h * 64 + c]; AUP[i] = P.a_up[(size_t)(z * 64 + r) * RW + h * 64 + c]; }
    float S[8];
#pragma unroll
    for (int j = 0; j < 8; ++j) S[j] = 0.f;
    const int c = tid & 63, sg = tid >> 6;
    const float w0c = P.w0[z * RW + h * 64 + c], a0c = P.a0[z * RW + h * 64 + c], kkc = P.k_k[h * 64 + c], kac = P.k_a[h * 64 + c], rkc = P.r_k[h * 64 + c];
    const int vrow = tid >> 3, ks = tid & 7;
    __syncthreads();
    for (int ch = 0; ch < T / TC; ++ch) {
        for (int i = tid; i < 5 * 2048; i += 512) {
            const int arr = i >> 11, rem = i & 2047, sl = rem >> 6, cc = rem & 63, s = ch * TC + sl, t = z ? (T - 1 - s) : s;
            const size_t row = (size_t)b * T + t;
            const bf16* src; int pitch, tapc;
            if (arr < 3) { src = P.RKV + arr * 512 + h * 64 + cc; pitch = 1536; tapc = arr * 512 + h * 64 + cc; }
            else { src = P.WA + (arr - 3) * 64 + cc; pitch = 128; tapc = 1536 + (arr - 3) * 64 + cc; }
            float val = P.taps[RSW + tapc] * bf2f(src[row * pitch]);
            if (t > 0) val += P.taps[tapc] * bf2f(src[(row - 1) * pitch]);
            if (t < T - 1) val += P.taps[2 * RSW + tapc] * bf2f(src[(row + 1) * pitch]);
            if (arr == 3) val = tanhf(val);
            RR[i] = val;
        }
        __syncthreads();
        {
            float wl[4], al[4];
#pragma unroll
            for (int j = 0; j < 4; ++j) { wl[j] = w0c; al[j] = a0c; }
            for (int r = 0; r < 64; r += 4) {
                float wu[4], au[4];
#pragma unroll
                for (int q = 0; q < 4; ++q) { wu[q] = WUP[(r + q) * 64 + c]; au[q] = AUP[(r + q) * 64 + c]; }
#pragma unroll
                for (int j = 0; j < 4; ++j) { const f32x4 wd = *(const LAS f32x4*)(WD + (4 * sg + j) * 64 + r), ad = *(const LAS f32x4*)(AD + (4 * sg + j) * 64 + r);
                    wl[j] += wd[0] * wu[0] + wd[1] * wu[1] + wd[2] * wu[2] + wd[3] * wu[3]; al[j] += ad[0] * au[0] + ad[1] * au[1] + ad[2] * au[2] + ad[3] * au[3]; }
            }
#pragma unroll
            for (int j = 0; j < 4; ++j) { const int sl = 4 * sg + j;
                const float w = __expf(-DECAY_SCALE * sigmoidf_(wl[j])), a = sigmoidf_(al[j]);
                const float kraw = KR[sl * 64 + c], kkv = kraw * kkc;
                const float ssq = wave_sum(kkv * kkv), kkn = kkv / sqrtf(ssq + L2_EPS);
                const float kt = kraw * (1.0f + (a - 1.0f) * kac);
                const float bon = wave_sum(RR[sl * 64 + c] * kt * rkc);
                WW[sl * 64 + c] = w; KK[sl * 64 + c] = kkn; AKK[sl * 64 + c] = a * kkn; KT[sl * 64 + c] = kt;
                if (lane == 0) BO[sl] = bon; }
        }
        __syncthreads();
        for (int sl = 0; sl < TC; ++sl) {
            const LAS float* pw = WW + sl * 64 + ks * 8; const LAS float* pk = KK + sl * 64 + ks * 8; const LAS float* pa = AKK + sl * 64 + ks * 8;
            const LAS float* pt = KT + sl * 64 + ks * 8; const LAS float* pr = RR + sl * 64 + ks * 8;
            const f32x4 w0v = *(const LAS f32x4*)pw, w1v = *(const LAS f32x4*)(pw + 4), k0v = *(const LAS f32x4*)pk, k1v = *(const LAS f32x4*)(pk + 4);
            const f32x4 a0v = *(const LAS f32x4*)pa, a1v = *(const LAS f32x4*)(pa + 4), t0v = *(const LAS f32x4*)pt, t1v = *(const LAS f32x4*)(pt + 4);
            const f32x4 r0v = *(const LAS f32x4*)pr, r1v = *(const LAS f32x4*)(pr + 4);
            const float vv = VV[sl * 64 + vrow];
            float sa = (S[0] * k0v[0] + S[1] * k0v[1]) + (S[2] * k0v[2] + S[3] * k0v[3]) + (S[4] * k1v[0] + S[5] * k1v[1]) + (S[6] * k1v[2] + S[7] * k1v[3]);
            sa += __shfl_xor(sa, 1); sa += __shfl_xor(sa, 2); sa += __shfl_xor(sa, 4);
#pragma unroll
            for (int j = 0; j < 4; ++j) { S[j] = S[j] * w0v[j] - sa * a0v[j] + vv * t0v[j]; S[4 + j] = S[4 + j] * w1v[j] - sa * a1v[j] + vv * t1v[j]; }
            float y = (S[0] * r0v[0] + S[1] * r0v[1]) + (S[2] * r0v[2] + S[3] * r0v[3]) + (S[4] * r1v[0] + S[5] * r1v[1]) + (S[6] * r1v[2] + S[7] * r1v[3]);
            y += __shfl_xor(y, 1); y += __shfl_xor(y, 2); y += __shfl_xor(y, 4);
            if (ks == 0) YO[sl * 64 + vrow] = y;
        }
        __syncthreads();
        for (int i = tid; i < 2048; i += 512) { const int sl = i >> 6, vc = i & 63, s = ch * TC + sl, t = z ? (T - 1 - s) : s;
            P.Y[((size_t)z * M + (size_t)b * T + t) * RW + h * 64 + vc] = YO[i]; }
        if (tid < TC) { const int s = ch * TC + tid, t = z ? (T - 1 - s) : s; P.BON[((size_t)z * M + (size_t)b * T + t) * 8 + h] = BO[tid]; }
    }
}
typedef unsigned u32x2 __attribute__((ext_vector_type(2)));
__device__ __forceinline__ unsigned cvtpk(float lo, float hi) { typedef float f2_ __attribute__((ext_vector_type(2))); typedef __bf16 b2_ __attribute__((ext_vector_type(2))); f2_ v = {lo, hi}; b2_ b = __builtin_convertvector(v, b2_); return __builtin_bit_cast(unsigned, b); }
template <int CTRL> __device__ __forceinline__ float dppf(float x) { return __builtin_bit_cast(float, __builtin_amdgcn_update_dpp(0, __builtin_bit_cast(int, x), CTRL, 0xf, 0xf, true)); }
__device__ __forceinline__ float reduce8(float x) { x += dppf<0xB1>(x); x += dppf<0x4E>(x); x += dppf<0x141>(x); return x; }
__device__ __forceinline__ float reduce16(float x) { x = reduce8(x); x += dppf<0x140>(x); return x; }
__device__ __forceinline__ bf16x8 frag_lo(f32x4 x) { v4u w = {cvtpk(x[0], x[1]), cvtpk(x[2], x[3]), 0u, 0u}; return __builtin_bit_cast(bf16x8, w); }
__device__ __forceinline__ bf16x8 frag_2(f32x4 x, f32x4 y) { v4u w = {cvtpk(x[0], x[1]), cvtpk(x[2], x[3]), cvtpk(y[0], y[1]), cvtpk(y[2], y[3])}; return __builtin_bit_cast(bf16x8, w); }
__device__ __forceinline__ bf16x8 frag_lo_u(u32x2 x) { v4u w = {x[0], x[1], 0u, 0u}; return __builtin_bit_cast(bf16x8, w); }
__device__ __forceinline__ f32x4 mfma16(bf16x8 a, bf16x8 b, f32x4 c) { return __builtin_amdgcn_mfma_f32_16x16x32_bf16(a, b, c, 0, 0, 0); }
__device__ __forceinline__ float fsig(float v) { return __builtin_amdgcn_rcpf(1.0f + __builtin_amdgcn_exp2f(-1.4426950408889634f * v)); }
__device__ __forceinline__ int kpos(int k) { return 32 * (k >> 5) + 8 * ((k >> 2) & 3) + 4 * ((k >> 4) & 1) + (k & 3); }
constexpr int O_WUPT = 0, O_AUPT = 8192, O_TAPS = 16384, O_CONST = 20480, O_RNS = 22528, O_BONS = 22784, O_GC = 23040, O_SHR = 24576, O_SHK = 40960, O_TW = 57344, O_AD = 65536, O_VT = 73728,
              O_AT = 81920, O_RT = 90112, O_BT = 98304, O_KT = 106496, O_BK = 114688, O_TA = 131072, O_AAK = 133120, O_ARBK = 135168, O_SCAN_END = 139264, O_YST = O_SHR;
constexpr float LOG2E = 1.4426950408889634f;
__device__ __forceinline__ void rwkv_scan_chunked(Frame& F, int unit) {
    const Ptrs P = load_ptrs(F);
    const int z = unit >> 7, b = (unit >> 3) & 15, h = unit & 7, tid0 = F.tid, w = F.wave;
#define OPAQUE_IDS int tid = tid0; asm volatile("" : "+v"(tid)); const int lane = tid & 63, fr = lane & 15, fq = lane >> 4; (void)lane; (void)fr; (void)fq;
    LAS unsigned char* L = F.lds;
    LAS float* TAPS = (LAS float*)(L + O_TAPS); LAS float* CST = (LAS float*)(L + O_CONST); LAS float* RNS = (LAS float*)(L + O_RNS); LAS float* BONS = (LAS float*)(L + O_BONS); LAS float* GC = (LAS float*)(L + O_GC);
    LAS float* SHR = (LAS float*)(L + O_SHR); LAS float* SHK = (LAS float*)(L + O_SHK); LAS float* YST = (LAS float*)(L + O_YST);
    { OPAQUE_IDS
    for (int i = tid; i < 4096; i += 512) { const int ch = i >> 6, rk = i & 63;
        ((LAS bf16*)(L + O_WUPT))[i] = (bf16)f2bf(P.w_up[(size_t)(z * 64 + rk) * RW + h * 64 + ch]); ((LAS bf16*)(L + O_AUPT))[i] = (bf16)f2bf(P.a_up[(size_t)(z * 64 + rk) * RW + h * 64 + ch]); }
    for (int i = tid; i < 960; i += 512) { const int j = i / 320, idx = i % 320; const int col = idx < 192 ? (idx >> 6) * 512 + h * 64 + (idx & 63) : 1536 + (idx - 192); TAPS[i] = P.taps[j * RSW + col]; }
    if (tid < 64) { CST[tid] = P.k_k[h * 64 + tid]; CST[64 + tid] = P.k_a[h * 64 + tid]; CST[128 + tid] = P.r_k[h * 64 + tid]; CST[192 + tid] = P.w0[z * RW + h * 64 + tid]; CST[256 + tid] = P.a0[z * RW + h * 64 + tid]; RNS[tid] = 0.f; }
    }
    f32x4 St[4];
#pragma unroll
    for (int i = 0; i < 4; ++i) St[i] = (f32x4){0.f, 0.f, 0.f, 0.f};
    __syncthreads();
    for (int n = 0; n < T / 64; ++n) {
        const int tlo = z ? (T - 64 * (n + 1)) : 64 * n;
        { OPAQUE_IDS
        if (w < 5) {
            const int cc = lane & 7, rg = lane >> 3, cchunk = w * 8 + cc, arr = w < 3 ? w : 3;
            const bf16* src; size_t pitch;
            if (arr < 3) { src = P.RKV + arr * 512 + h * 64 + cc * 8; pitch = 1536; } else { src = P.WA + (cchunk - 24) * 8; pitch = 128; }
            v4u x[10];
#pragma unroll
            for (int i = 0; i < 10; ++i) { const int t = tlo - 1 + 8 * rg + i; x[i] = (t >= 0 && t < T) ? *(const GAS v4u*)(src + ((size_t)b * T + t) * pitch) : (v4u){0u, 0u, 0u, 0u}; }
            float tp[3][8];
#pragma unroll
            for (int j = 0; j < 3; ++j) { const f32x4 a = *(const LAS f32x4*)(TAPS + j * 320 + cchunk * 8), c = *(const LAS f32x4*)(TAPS + j * 320 + cchunk * 8 + 4);
                tp[j][0] = a[0]; tp[j][1] = a[1]; tp[j][2] = a[2]; tp[j][3] = a[3]; tp[j][4] = c[0]; tp[j][5] = c[1]; tp[j][6] = c[2]; tp[j][7] = c[3]; }
            float kc[8];
            if (arr == 1) {
#pragma unroll
                for (int e = 0; e < 8; ++e) kc[e] = CST[cc * 8 + e]; }
            unsigned vpk[8][4];
#pragma unroll
            for (int o = 0; o < 8; ++o) {
                const int sl = z ? (63 - 8 * rg - o) : (8 * rg + o);
                float val[8];
#pragma unroll
                for (int e = 0; e < 8; ++e) { const int d = e >> 1;
                    const float x0 = (e & 1) ? __uint_as_float(x[o][d] & 0xffff0000u) : __uint_as_float(x[o][d] << 16);
                    const float x1 = (e & 1) ? __uint_as_float(x[o + 1][d] & 0xffff0000u) : __uint_as_float(x[o + 1][d] << 16);
                    const float x2 = (e & 1) ? __uint_as_float(x[o + 2][d] & 0xffff0000u) : __uint_as_float(x[o + 2][d] << 16);
                    val[e] = tp[0][e] * x0 + tp[1][e] * x1 + tp[2][e] * x2; }
                if (arr == 0) { *(LAS f32x4*)(SHR + sl * 64 + cc * 8) = (f32x4){val[0], val[1], val[2], val[3]}; *(LAS f32x4*)(SHR + sl * 64 + cc * 8 + 4) = (f32x4){val[4], val[5], val[6], val[7]}; }
                else if (arr == 1) { *(LAS f32x4*)(SHK + sl * 64 + cc * 8) = (f32x4){val[0], val[1], val[2], val[3]}; *(LAS f32x4*)(SHK + sl * 64 + cc * 8 + 4) = (f32x4){val[4], val[5], val[6], val[7]};
                    float ss = 0.f;
#pragma unroll
                    for (int e = 0; e < 8; ++e) { const float q = val[e] * kc[e]; ss += q * q; }
                    __hip_atomic_fetch_add(RNS + sl, ss, __ATOMIC_RELAXED, __HIP_MEMORY_SCOPE_WORKGROUP); }
                else if (arr == 2) {
#pragma unroll
                    for (int e = 0; e < 8; ++e) { const unsigned hb = cvtpk(val[e], 0.f); if (o & 1) vpk[e][o >> 1] |= hb << 16; else vpk[e][o >> 1] = hb; }
                }
                else { const bool iswd = cchunk < 32;
                    if (iswd) {
#pragma unroll
                        for (int e = 0; e < 8; ++e) { const float ex = __builtin_amdgcn_exp2f(2.0f * LOG2E * val[e]); val[e] = 1.0f - 2.0f * __builtin_amdgcn_rcpf(ex + 1.0f); } }
                    v4u wv = {cvtpk(val[0], val[1]), cvtpk(val[2], val[3]), cvtpk(val[4], val[5]), cvtpk(val[6], val[7])};
                    *(LAS v4u*)(L + (iswd ? O_TW : O_AD) + sl * 128 + (cchunk & 7) * 16) = wv; }
            }
            if (arr == 2) { const int sl0 = z ? (56 - 8 * rg) : 8 * rg;
#pragma unroll
                for (int e = 0; e < 8; ++e) { v4u o4;
                    if (z) o4 = (v4u){(vpk[e][3] >> 16) | (vpk[e][3] << 16), (vpk[e][2] >> 16) | (vpk[e][2] << 16), (vpk[e][1] >> 16) | (vpk[e][1] << 16), (vpk[e][0] >> 16) | (vpk[e][0] << 16)};
                    else o4 = (v4u){vpk[e][0], vpk[e][1], vpk[e][2], vpk[e][3]};
                    *(LAS v4u*)(L + O_VT + (cc * 8 + e) * 128 + sl0 * 2) = o4; } }
        } else if (w == 5) BONS[lane] = 0.f;
        }
        __syncthreads();
        { OPAQUE_IDS
            const int mt = w >> 1;
            const bf16x8 tw0 = *(const LAS bf16x8*)(L + O_TW + (16 * mt + fr) * 128 + fq * 16), tw1 = *(const LAS bf16x8*)(L + O_TW + (16 * mt + fr) * 128 + 64 + fq * 16);
            const bf16x8 ad0 = *(const LAS bf16x8*)(L + O_AD + (16 * mt + fr) * 128 + fq * 16), ad1 = *(const LAS bf16x8*)(L + O_AD + (16 * mt + fr) * 128 + 64 + fq * 16);
#pragma unroll
            for (int gi = 0; gi < 2; ++gi) {
                const int ng = 2 * (w & 1) + gi, ch = 16 * ng + fr, cp = kpos(ch);
                const bf16x8 wu0 = *(const LAS bf16x8*)(L + O_WUPT + ch * 128 + fq * 16), wu1 = *(const LAS bf16x8*)(L + O_WUPT + ch * 128 + 64 + fq * 16);
                const bf16x8 au0 = *(const LAS bf16x8*)(L + O_AUPT + ch * 128 + fq * 16), au1 = *(const LAS bf16x8*)(L + O_AUPT + ch * 128 + 64 + fq * 16);
                f32x4 accw = mfma16(tw0, wu0, (f32x4){0.f, 0.f, 0.f, 0.f}); accw = mfma16(tw1, wu1, accw);
                f32x4 acca = mfma16(ad0, au0, (f32x4){0.f, 0.f, 0.f, 0.f}); acca = mfma16(ad1, au1, acca);
                const float kkc = CST[ch], kac = CST[64 + ch], rkc = CST[128 + ch], w0c = CST[192 + ch], a0c = CST[256 + ch];
                float lw[4], g[4];
#pragma unroll
                for (int r = 0; r < 4; ++r) lw[r] = -(DECAY_SCALE * LOG2E) * fsig(accw[r] + w0c);
                g[0] = lw[0]; g[1] = g[0] + lw[1]; g[2] = g[1] + lw[2]; g[3] = g[2] + lw[3];
                const float t0 = __shfl(g[3], fr), t1 = __shfl(g[3], fr + 16), t2 = __shfl(g[3], fr + 32), t3 = __shfl(g[3], fr + 48);
                const float ex = (fq > 0 ? t0 : 0.f) + (fq > 1 ? t1 : 0.f) + (fq > 2 ? t2 : 0.f), gC = (t0 + t1) + (t2 + t3);
                float bh[4], kh[4];
#pragma unroll
                for (int r = 0; r < 4; ++r) {
                    const int sl = 16 * mt + 4 * fq + r;
                    const float gi_ = ex + g[r], gm1 = gi_ - lw[r];
                    const float rsh = SHR[sl * 64 + ch], ksh = SHK[sl * 64 + ch], rn = __builtin_amdgcn_rsqf(RNS[sl] + L2_EPS);
                    const float a = fsig(acca[r] + a0c);
                    const float kk = ksh * kkc * rn, kt = ksh * (1.0f + (a - 1.0f) * kac), akk = a * kk;
                    const float e1 = __builtin_amdgcn_exp2f(gm1), e2 = __builtin_amdgcn_exp2f(-gi_), e3 = __builtin_amdgcn_exp2f(gi_), e4 = __builtin_amdgcn_exp2f(gC - gi_);
                    ((LAS bf16*)(L + O_AT))[sl * 64 + cp] = (bf16)cvtpk(-kk * e1, 0.f);
                    ((LAS bf16*)(L + O_BT))[sl * 64 + cp] = (bf16)cvtpk(akk * e2, 0.f);
                    ((LAS bf16*)(L + O_KT))[sl * 64 + cp] = (bf16)cvtpk(kt * e2, 0.f);
                    ((LAS bf16*)(L + O_RT))[sl * 64 + cp] = (bf16)cvtpk(rsh * e3, 0.f);
                    bh[r] = akk * e4; kh[r] = kt * e4;
                    float bon = rsh * kt * rkc;
                    bon = reduce16(bon);
                    if (fr == 0) __hip_atomic_fetch_add(BONS + sl, bon, __ATOMIC_RELAXED, __HIP_MEMORY_SCOPE_WORKGROUP);
                }
                *(LAS v4u*)(L + O_BK + ((mt * 64 + ch) * 32 + fq * 8) * 2) = (v4u){cvtpk(bh[0], bh[1]), cvtpk(bh[2], bh[3]), cvtpk(kh[0], kh[1]), cvtpk(kh[2], kh[3])};
                if (fq == 0) GC[mt * 64 + ch] = __builtin_amdgcn_exp2f(gC);
            }
        }
        __syncthreads();
        { OPAQUE_IDS
            const int ck = w & 3; const f32x4 Z4 = (f32x4){0.f, 0.f, 0.f, 0.f};
            const int ro = (16 * ck + fr) * 128 + fq * 16;
            const bf16x8 af0 = *(const LAS bf16x8*)(L + O_AT + ro), af1 = *(const LAS bf16x8*)(L + O_AT + ro + 64);
            if (w < 4) {
                const bf16x8 bf0 = *(const LAS bf16x8*)(L + O_BT + ro), bf1 = *(const LAS bf16x8*)(L + O_BT + ro + 64);
                f32x4 X = mfma16(af0, bf0, Z4); X = mfma16(af1, bf1, X);
                f32x4 XT = mfma16(bf0, af0, Z4); XT = mfma16(bf1, af1, XT);
#pragma unroll
                for (int r = 0; r < 4; ++r) { if (!(fr < 4 * fq + r)) X[r] = 0.f; if (!(4 * fq + r < fr)) XT[r] = 0.f; }
                bf16x8 cx = frag_lo(X), cxt = frag_lo(XT);
                f32x4 X2 = mfma16(cxt, cx, Z4), X2T = mfma16(cx, cxt, Z4);
                bf16x8 c2 = frag_lo(X2), c2t = frag_lo(X2T);
                f32x4 X4 = mfma16(c2t, c2, Z4), X4T = mfma16(c2, c2t, Z4);
                bf16x8 c4 = frag_lo(X4), c4t = frag_lo(X4T);
                f32x4 X8 = mfma16(c4t, c4, Z4);
                f32x4 Q = XT;
#pragma unroll
                for (int r = 0; r < 4; ++r) if (4 * fq + r == fr) Q[r] += 1.0f;
                Q = mfma16(c2, frag_lo(Q), Q);
                Q = mfma16(c4, frag_lo(Q), Q);
                Q = mfma16(frag_lo(X8), frag_lo(Q), Q);
                *(LAS u32x2*)(L + O_TA + ((16 * ck + fr) * 16 + 4 * fq) * 2) = (u32x2){cvtpk(Q[0], Q[1]), cvtpk(Q[2], Q[3])};
            } else {
                const bf16x8 bf0 = *(const LAS bf16x8*)(L + O_BT + ro), bf1 = *(const LAS bf16x8*)(L + O_BT + ro + 64);
                const bf16x8 kf0 = *(const LAS bf16x8*)(L + O_KT + ro), kf1 = *(const LAS bf16x8*)(L + O_KT + ro + 64);
                const bf16x8 rf0 = *(const LAS bf16x8*)(L + O_RT + ro), rf1 = *(const LAS bf16x8*)(L + O_RT + ro + 64);
                f32x4 AkT = mfma16(kf0, af0, Z4); AkT = mfma16(kf1, af1, AkT);
                f32x4 RbT = mfma16(bf0, rf0, Z4); RbT = mfma16(bf1, rf1, RbT);
                f32x4 RkT = mfma16(kf0, rf0, Z4); RkT = mfma16(kf1, rf1, RkT);
#pragma unroll
                for (int r = 0; r < 4; ++r) { if (!(4 * fq + r < fr)) AkT[r] = 0.f; if (!(4 * fq + r <= fr)) { RbT[r] = 0.f; RkT[r] = 0.f; } }
                *(LAS u32x2*)(L + O_AAK + ((16 * ck + fr) * 16 + 4 * fq) * 2) = (u32x2){cvtpk(AkT[0], AkT[1]), cvtpk(AkT[2], AkT[3])};
                *(LAS v4u*)(L + O_ARBK + ((16 * ck + fr) * 32 + 8 * fq) * 2) = (v4u){cvtpk(RbT[0], RbT[1]), cvtpk(RbT[2], RbT[3]), cvtpk(RkT[0], RkT[1]), cvtpk(RkT[2], RkT[3])};
            }
        }
        __syncthreads();
        { OPAQUE_IDS
        if (w < 4) {
#pragma unroll 1
            for (int ck = 0; ck < 4; ++ck) {
                const int ro = (16 * ck + fr) * 128 + fq * 16; const f32x4 Z4 = (f32x4){0.f, 0.f, 0.f, 0.f};
                const bf16x8 af0 = *(const LAS bf16x8*)(L + O_AT + ro), af1 = *(const LAS bf16x8*)(L + O_AT + ro + 64);
                const bf16x8 rf0 = *(const LAS bf16x8*)(L + O_RT + ro), rf1 = *(const LAS bf16x8*)(L + O_RT + ro + 64);
                const bf16x8 aakf = frag_lo_u(*(const LAS u32x2*)(L + O_AAK + ((16 * ck + fr) * 16 + 4 * fq) * 2));
                const bf16x8 taf = frag_lo_u(*(const LAS u32x2*)(L + O_TA + ((16 * ck + fr) * 16 + 4 * fq) * 2));
                const bf16x8 arbkf = *(const LAS bf16x8*)(L + O_ARBK + ((16 * ck + fr) * 32 + 8 * fq) * 2);
                const u32x2 vv = *(const LAS u32x2*)(L + O_VT + (16 * w + fr) * 128 + (16 * ck + 4 * fq) * 2);
                const bf16x8 sb01 = frag_2(St[0], St[1]), sb23 = frag_2(St[2], St[3]);
                f32x4 U0 = mfma16(aakf, frag_lo_u(vv), Z4); U0 = mfma16(af0, sb01, U0); U0 = mfma16(af1, sb23, U0);
                const f32x4 U = mfma16(taf, frag_lo(U0), Z4);
                v4u uvw = {cvtpk(U[0], U[1]), cvtpk(U[2], U[3]), vv[0], vv[1]}; const bf16x8 uvb = __builtin_bit_cast(bf16x8, uvw);
                f32x4 Y = mfma16(rf0, sb01, Z4); Y = mfma16(rf1, sb23, Y); Y = mfma16(arbkf, uvb, Y);
#pragma unroll
                for (int kt = 0; kt < 4; ++kt) {
                    const f32x4 gc = *(const LAS f32x4*)(GC + ck * 64 + 16 * kt + 4 * fq);
                    const bf16x8 bkf = *(const LAS bf16x8*)(L + O_BK + ((ck * 64 + 16 * kt + fr) * 32 + 8 * fq) * 2);
                    St[kt] = mfma16(bkf, uvb, St[kt] * gc);
                }
#pragma unroll
                for (int r = 0; r < 4; ++r) YST[(16 * ck + 4 * fq + r) * 64 + 16 * w + fr] = Y[r];
            }
        } else if (w == 4) RNS[lane] = 0.f;
        }
        __syncthreads();
        { OPAQUE_IDS
        { const int sl = tid >> 3, v8 = (tid & 7) * 8, t = z ? (tlo + 63 - sl) : (tlo + sl);
          const f32x4 ya = *(const LAS f32x4*)(YST + sl * 64 + v8), yb = *(const LAS f32x4*)(YST + sl * 64 + v8 + 4);
          *(GAS v4u*)((bf16*)P.Y + ((size_t)z * M + (size_t)b * T + t) * RW + h * 64 + v8) = (v4u){cvtpk(ya[0], ya[1]), cvtpk(ya[2], ya[3]), cvtpk(yb[0], yb[1]), cvtpk(yb[2], yb[3])}; }
        if (tid < 64) { const int t = z ? (tlo + 63 - tid) : (tlo + tid); P.BON[((size_t)z * M + (size_t)b * T + t) * 8 + h] = BONS[tid]; }
        }
        __syncthreads();
    }
#undef OPAQUE_IDS
}
static_assert(O_SCAN_END <= RING_BYTES, "scan LDS");
__device__ __forceinline__ void unpack8(const v4u p, float (&f)[8]) {
#pragma unroll
    for (int d = 0; d < 4; ++d) { f[2 * d] = __uint_as_float(p[d] << 16); f[2 * d + 1] = __uint_as_float(p[d] & 0xffff0000u); } }
__device__ __forceinline__ void mix_prep(Frame& F) {
    const Ptrs P = load_ptrs(F);
    const int gw = F.vcu * NWAVES + F.wave, NGW = F.G * NWAVES, lane = F.lane, hh = lane >> 3, col = hh * 64 + (lane & 7) * 8;
    float gw8[8], gb8[8], tp0[8], tp1[8], tp2[8];
#pragma unroll
    for (int e = 0; e < 8; ++e) { gw8[e] = P.gn_w[col + e]; gb8[e] = P.gn_b[col + e]; tp0[e] = P.taps[1024 + col + e]; tp1[e] = P.taps[RSW + 1024 + col + e]; tp2[e] = P.taps[2 * RSW + 1024 + col + e]; }
    const bf16* Yb = (const bf16*)P.Y;
    for (int m = gw; m < M; m += NGW) {
        const int t = m & (T - 1);
        const v4u y0p = *(const GAS v4u*)(Yb + (size_t)m * RW + col), y1p = *(const GAS v4u*)(Yb + ((size_t)M + m) * RW + col);
        const v4u gp = *(const GAS v4u*)(P.GRW + (size_t)m * 512 + col);
        const bf16* vsrc = P.RKV + 1024 + col;
        const v4u v1p = *(const GAS v4u*)(vsrc + (size_t)m * 1536);
        const v4u v0p = (t > 0) ? *(const GAS v4u*)(vsrc + (size_t)(m - 1) * 1536) : (v4u){0u, 0u, 0u, 0u};
        const v4u v2p = (t < T - 1) ? *(const GAS v4u*)(vsrc + (size_t)(m + 1) * 1536) : (v4u){0u, 0u, 0u, 0u};
        const float bon = P.BON[(size_t)m * 8 + hh] + P.BON[((size_t)M + m) * 8 + hh];
        float y0[8], y1[8], g[8], v0[8], v1[8], v2[8], y[8];
        unpack8(y0p, y0); unpack8(y1p, y1); unpack8(gp, g); unpack8(v0p, v0); unpack8(v1p, v1); unpack8(v2p, v2);
        float s = 0.f;
#pragma unroll
        for (int e = 0; e < 8; ++e) { y[e] = y0[e] + y1[e]; s += y[e]; }
        const float mu = reduce8(s) * (1.0f / 64.0f); float q = 0.f;
#pragma unroll
        for (int e = 0; e < 8; ++e) { y[e] -= mu; q += y[e] * y[e]; }
        const float rstd = __builtin_amdgcn_rsqf(reduce8(q) * (1.0f / 64.0f) + GN_EPS);
        float o[8];
#pragma unroll
        for (int e = 0; e < 8; ++e) { const float vs = tp0[e] * v0[e] + tp1[e] * v1[e] + tp2[e] * v2[e]; o[e] = (y[e] * rstd * gw8[e] + gb8[e] + bon * vs) * g[e]; }
        *(GAS v4u*)(P.MIX + (size_t)m * D + 512 + col) = (v4u){cvtpk(o[0], o[1]), cvtpk(o[2], o[3]), cvtpk(o[4], o[5]), cvtpk(o[6], o[7])};
    }
}
__device__ __forceinline__ void final_norm(Frame& F) {
    const Ptrs P = load_ptrs(F);
    const int gw = F.vcu * NWAVES + F.wave, NGW = F.G * NWAVES;
    for (int m = gw; m < M; m += NGW) {
        const int b = m / T;
        const GAS f32x4* orow = (const GAS f32x4*)(P.OUTPRE + (size_t)m * D) + F.lane; const GAS f32x4* xr = (const GAS f32x4*)(P.x + (size_t)m * D) + F.lane;
        f32x4 v[4]; float s = 0.f;
#pragma unroll
        for (int j = 0; j < 4; ++j) { v[j] = orow[64 * j]; s += (v[j].x * v[j].x + v[j].y * v[j].y) + (v[j].z * v[j].z + v[j].w * v[j].w); }
        const float rstd = 1.f / sqrtf(wave_sum(s) * (1.f / D) + NORM_EPS);
        GAS f32x4* o = (GAS f32x4*)(P.out + (size_t)m * D) + F.lane;
#pragma unroll
        for (int j = 0; j < 4; ++j) { const int d0 = 256 * j + 4 * F.lane; const f32x4 gp = *(const GAS f32x4*)(P.g_post + d0), gt = *(const GAS f32x4*)(P.MOD + b * 3 * D + 2 * D + d0);
            o[64 * j] = xr[64 * j] + gt * (v[j] * rstd * gp); }
    }
}

struct Args { const float* in[20]; float* out; unsigned char* ws; int ph_lo, ph_hi, li, pad; };
__global__ void __launch_bounds__(NWAVES * 64, 2) hyb_fwd(Args args) {
    extern __shared__ __attribute__((aligned(16))) unsigned char lds[];
    Frame F;
    F.lds = (LAS unsigned char*)lds;
    F.MISC = (volatile LAS unsigned*)(F.lds + MISC_OFF);
    F.tid = threadIdx.x; F.lane = F.tid & 63; F.wave = __builtin_amdgcn_readfirstlane(F.tid >> 6);
    F.G = gridDim.x; { const int bx = blockIdx.x; F.vcu = (F.G % 8 == 0) ? (bx % 8) * (F.G / 8) + bx / 8 : bx; }
#define GRID_BAR(seam) do { if (N_LAUNCHES == PER_PHASE) { if (F.tid == 0) __hip_atomic_store(F.ctl + CW_TMO, 0xBADBA0u | (unsigned)(seam), RLX_AGENT); } \
    else { xcd_barrier(bar); } } while (0)
    F.kp = (const CAS char*)__builtin_amdgcn_kernarg_segment_ptr();
    F.ctl = (gu32*)(args.ws + WS_CTL);
    for (int u = F.tid; u < (LDS_BYTES - LDSCTL_OFF) / 4; u += NWAVES * 64) ((LAS unsigned*)(F.lds + LDSCTL_OFF))[u] = 0u;
    __syncthreads();
    XcdBarrier bar; bar.bar = (unsigned*)(F.ctl + CW_BAR); bar.x = 0; bar.st = nullptr;
    if (N_LAUNCHES != PER_PHASE) bar = xcd_barrier_post((unsigned*)(F.ctl + CW_BAR), F.MISC + 8);

    const int lo = args.ph_lo, hi = args.ph_hi;
#define IN(k) (lo <= (k) && (k) < hi)
#ifndef PROBE_REPEAT
#define PROBE_REPEAT -1
#endif
#define REP(k) for (int rep_ = 0; rep_ < ((PROBE_REPEAT == (k)) ? 2 : 1); ++rep_)
#define BOTH(k) (IN(k) && IN((k) + 1))
    if (IN(0)) { p0_prologue(F); if (BOTH(0)) GRID_BAR(0); }
    if (IN(1)) { REP(1) p1_xn(F); if (BOTH(1)) GRID_BAR(1); }
    if (IN(2)) {
        const Ptrs P = load_ptrs(F);
        pg8::Gemm g{P.XN, P.Win_t, M, NINP, D}; pg8::StaticOrder S; S.init(M, NINP, F.G, (int)blockIdx.x);
        EpiInProj E{P.QB, P.KB, P.VB, P.GATT, P.RKV, P.WA, P.GRW, P.q_norm_g, P.k_norm_g, P.ROPE, attn_body::C2};
        REP(2) pg8::gemm_phase<EpiInProj, pg8::StaticOrder, PG8_ALIGN, PG8_SP2>(F.lds + RING_OFF, g, S, E);
        if (BOTH(2)) GRID_BAR(2);
    }
    if (IN(3)) {
        { const Ptrs P = load_ptrs(F);
        const attn_body::AttnTensors AT{(const attn_body::bf16*)P.QB, (const attn_body::bf16*)P.KB, (const attn_body::bf16*)P.VB, (const attn_body::bf16*)P.GATT, (attn_body::bf16*)P.MIX};
        const attn_body::StaticOrder S((int)F.G, (int)blockIdx.x);
        REP(3) attn_body::attn_phase<attn_body::StaticOrder>((char*)lds + RING_OFF, AT, S); }
        __syncthreads();
#if defined(RWKV_SEQ)
        for (int u = F.vcu; u < 256; u += F.G) { rwkv_scan_seq(F, u); __syncthreads(); }
#else
        REP(7) for (int u = F.vcu; u < 256; u += F.G) { rwkv_scan_chunked(F, u); __syncthreads(); }
#endif
        if (BOTH(3)) GRID_BAR(3);
    }
    if (IN(4)) { REP(4) mix_prep(F); if (BOTH(4)) GRID_BAR(4); }
    if (IN(5)) {
        const Ptrs P = load_ptrs(F);
        pg8::Gemm g{P.MIX, P.Wout_t, M, D, D}; pg8::StaticOrder S; S.init(M, D, F.G, (int)blockIdx.x);
        EpiF32 E{P.OUTPRE, D};
        REP(5) pg8::gemm_phase<EpiF32, pg8::StaticOrder, PG8_ALIGN, PG8_SP2>(F.lds + RING_OFF, g, S, E);
        if (BOTH(5)) GRID_BAR(5);
    }
    if (IN(6)) { REP(6) final_norm(F); }
#undef IN
#undef BOTH
}

extern "C" void kernel_launch(void* const* d_in, const int* in_sizes, int n_in, void* d_out, int out_size, void* d_ws, size_t ws_size, hipStream_t stream) {
    static int grid = 0;
    if (grid == 0) {
        if (n_in != 20 || in_sizes[0] != M * D || out_size != M * D || ws_size < WS_END) { fprintf(stderr, "kernel_launch: unexpected shapes (n_in %d, in0 %d, out %d, ws %zu); nothing launched\n", n_in, n_in > 0 ? in_sizes[0] : -1, out_size, ws_size); grid = -1; return; }
        int dev = 0, cus = 0, per_cu = 0;
        if (hipGetDevice(&dev) != hipSuccess || hipDeviceGetAttribute(&cus, hipDeviceAttributeMultiprocessorCount, dev) != hipSuccess) { grid = -1; return; }
        if (hipFuncSetAttribute((const void*)hyb_fwd, hipFuncAttributeMaxDynamicSharedMemorySize, LDS_BYTES) != hipSuccess) { fprintf(stderr, "kernel_launch: hipFuncSetAttribute failed\n"); grid = -1; return; }
        if (hipOccupancyMaxActiveBlocksPerMultiprocessor(&per_cu, (const void*)hyb_fwd, NWAVES * 64, LDS_BYTES) != hipSuccess || per_cu < 1)
            fprintf(stderr, "kernel_launch: note: occupancy query reports %d workgroups per CU\n", per_cu);
        (void)hipGetLastError();
        grid = cus;
    }
    if (grid < 0) return;
    if (hipMemsetAsync((char*)d_ws + WS_CTL, 0, CTL_ZERO_BYTES, stream) != hipSuccess) { fprintf(stderr, "kernel_launch: hipMemsetAsync failed\n"); return; }
    Args a{};
    for (int i = 0; i < 20; ++i) a.in[i] = (const float*)d_in[i];
    a.out = (float*)d_out; a.ws = (unsigned char*)d_ws;
    for (int li = 0; li < N_LAUNCHES; ++li) {
        a.ph_lo = (N_LAUNCHES == PER_PHASE) ? li : 0; a.ph_hi = (N_LAUNCHES == PER_PHASE) ? li + 1 : PER_PHASE; a.li = li;
        hipLaunchKernelGGL(hyb_fwd, dim3(grid), dim3(NWAVES * 64), LDS_BYTES, stream, a);
        const hipError_t le = hipPeekAtLastError();
        if (le != hipSuccess) { fprintf(stderr, "kernel_launch: launch %d failed: %s\n", li, hipGetErrorName(le)); break; }
    }
}
```

```cpp
#include <hip/hip_runtime.h>
#include <cstdio>
#include <cstdint>
namespace pg8 {
#define PG8_LAS __attribute__((address_space(3)))
typedef unsigned short bf16_t;
typedef short bf16x8 __attribute__((ext_vector_type(8)));
typedef float f32x4 __attribute__((ext_vector_type(4)));
typedef unsigned u32x4 __attribute__((ext_vector_type(4)));
constexpr int BM = 256, BK = 64, HALF = 128, HTB = HALF * BK * 2  , STAGE_BYTES = 8 * HTB, NXCD = 8, WGM = 8;

__host__ __device__ __forceinline__ int lds_byte(int r, int c) { const int st = (r >> 4) * 2 + (c >> 5), rr = r & 15, cc = c & 31, ob = rr * 64 + cc * 2; return st * 1024 + (ob ^ (((ob >> 9) & 1) << 5)); }
__host__ __device__ __forceinline__ void stage_rc(int b, int& R, int& C) { const int st = b / 1024, sb = b % 1024, swz = sb ^ (((sb >> 9) & 1) << 5); R = (st >> 1) * 16 + swz / 64; C = (st & 1) * 32 + (swz % 64) / 2; }
__host__ __device__ __forceinline__ int perm32(int rho) { const int n = rho >> 4, i = rho & 15; return 8 * (i >> 2) + 4 * n + (i & 3); }

struct Unit { int pm, pn; };
struct Gemm { const bf16_t* A; const bf16_t* Bt; int M, N, K; };

struct StaticOrder {
    int nM, nN, nwg, G, c;
    __host__ __device__ void init(int M, int N, int G_, int c_) { nM = M / BM; nN = N / BM; nwg = nM * nN; G = G_; c = c_; }
    __host__ __device__ bool next(int i, Unit& u) const {
        const long L = (long)i * G + c; if (L >= nwg) return false;
        int wgid = (int)L; { const int q = nwg / NXCD, r = nwg % NXCD, xcd = wgid % NXCD, off = wgid / NXCD; wgid = (xcd < r ? xcd * (q + 1) : r * (q + 1) + (xcd - r) * q) + off; }
        const int nig = WGM * nN, gid = wgid / nig, fm = gid * WGM, gsz = (nM - fm) < WGM ? (nM - fm) : WGM;
        u.pm = fm + ((wgid % nig) % gsz); u.pn = (wgid % nig) / gsz; return true;
    }
    __device__ __forceinline__ void a_ready(const Unit&) const {}
    __device__ __forceinline__ void done(const Unit&) const {}
};

__device__ __forceinline__ unsigned cvt_pk_bf16(float lo, float hi) { unsigned r; asm volatile("v_cvt_pk_bf16_f32 %0, %1, %2" : "=v"(r) : "v"(lo), "v"(hi)); return r; }
template <class Epi, class Sched, bool ALIGN_EPI = false, bool SP2 = false>
__device__ __forceinline__ void gemm_phase(PG8_LAS unsigned char* lds, const Gemm g, const Sched& S, const Epi& E) {
    const int tid = threadIdx.x, wid = __builtin_amdgcn_readfirstlane(tid >> 6), lane = tid & 63, wr = wid >> 2, wc = wid & 3, fr = lane & 15, fq = lane >> 4;
    const int K = g.K, nt = K / BK;
    unsigned voffA[2], voffB[2];
#pragma unroll
    for (int i = 0; i < 2; ++i) { int R, C; stage_rc(tid * 16 + i * 8192, R, C); const int Rb = Epi::PERM ? ((R & ~31) + perm32(R & 31)) : R;
        voffA[i] = (unsigned)(R * K + C) * 2u; voffB[i] = (unsigned)(Rb * K + C) * 2u; }
    const size_t kstep = (size_t)(BK * 2);
    const size_t hstep = (size_t)HALF * K * 2;
    const size_t tstep = 2 * hstep;
    const unsigned ldsw = (unsigned)wid * 1024u;
    const int aoff = lds_byte(wr * 64 + fr, fq * 8), boff = lds_byte(wc * 32 + fr, fq * 8);
#define PG8_SA(b, h) (((b) * 2 + (h)) * HTB)
#define PG8_SB(b, h) ((4 + (b) * 2 + (h)) * HTB)
#define PG8_STAGE(bufoff, gbase, voff) do { _Pragma("unroll") for (int _i = 0; _i < 2; ++_i) \
        __builtin_amdgcn_global_load_lds((const unsigned*)((const char*)(gbase) + (voff)[_i]), (PG8_LAS unsigned*)(lds + (bufoff) + ldsw + _i * 8192), 16, 0, 0); } while (0)
#define PG8_LDA(dst, b, h) do { _Pragma("unroll") for (int m = 0; m < 4; ++m) _Pragma("unroll") for (int k = 0; k < 2; ++k) dst[m][k] = *(const PG8_LAS bf16x8*)(lds + PG8_SA(b, h) + aoff + m * 2048 + k * 1024); } while (0)
#define PG8_LDB(dst, b, h) do { _Pragma("unroll") for (int n = 0; n < 2; ++n) _Pragma("unroll") for (int k = 0; k < 2; ++k) dst[n][k] = *(const PG8_LAS bf16x8*)(lds + PG8_SB(b, h) + boff + n * 2048 + k * 1024); } while (0)
#define PG8_MMA(ai, bj, At, Bt) do { __builtin_amdgcn_s_setprio(1); _Pragma("unroll") for (int m = 0; m < 4; ++m) _Pragma("unroll") for (int n = 0; n < 2; ++n) _Pragma("unroll") for (int k = 0; k < 2; ++k) \
        acc[ai][bj][m][n] = __builtin_amdgcn_mfma_f32_16x16x32_bf16(Bt[n][k], At[m][k], acc[ai][bj][m][n], 0, 0, 0); __builtin_amdgcn_s_setprio(0); } while (0)
#define PG8_WAIT_V(n) asm volatile("s_waitcnt vmcnt(" #n ")" ::: "memory")
#define PG8_WAIT_L(n) asm volatile("s_waitcnt lgkmcnt(" #n ")" ::: "memory")
#define PG8_BAR __builtin_amdgcn_s_barrier()
#define PG8_SCHED __builtin_amdgcn_sched_barrier(0)
    Unit cur, nxt; int ui = 0;
    if (!S.next(0, cur)) return;
    f32x4 acc[2][2][4][2];
#pragma unroll
    for (int a = 0; a < 2; ++a)
#pragma unroll
        for (int b = 0; b < 2; ++b)
#pragma unroll
            for (int m = 0; m < 4; ++m)
#pragma unroll
                for (int n = 0; n < 2; ++n) acc[a][b][m][n] = (f32x4){0.f, 0.f, 0.f, 0.f};
    bf16x8 At[4][2], B0[2][2], B1[2][2];
    const char* cA = (const char*)g.A + (size_t)cur.pm * tstep; const char* cB = (const char*)g.Bt + (size_t)cur.pn * tstep;
    S.a_ready(cur);
    if constexpr (SP2) {
        PG8_STAGE(PG8_SB(0, 0), cB, voffB); PG8_STAGE(PG8_SB(0, 1), cB + hstep, voffB); PG8_STAGE(PG8_SA(0, 0), cA, voffA); PG8_STAGE(PG8_SA(0, 1), cA + hstep, voffA);
        if (wr == 1) PG8_BAR;
        PG8_WAIT_V(2); PG8_BAR;
        PG8_STAGE(PG8_SB(1, 0), cB + kstep, voffB); PG8_STAGE(PG8_SA(1, 0), cA + kstep, voffA); PG8_STAGE(PG8_SB(1, 1), cB + hstep + kstep, voffB);
        PG8_WAIT_V(6); PG8_BAR;
    } else {
        PG8_STAGE(PG8_SB(0, 0), cB, voffB); PG8_STAGE(PG8_SA(0, 0), cA, voffA); PG8_STAGE(PG8_SB(0, 1), cB + hstep, voffB); PG8_STAGE(PG8_SA(0, 1), cA + hstep, voffA);
        if (wr == 1) PG8_BAR;
        PG8_WAIT_V(4); PG8_BAR;
        PG8_STAGE(PG8_SB(1, 0), cB + kstep, voffB); PG8_STAGE(PG8_SA(1, 0), cA + kstep, voffA); PG8_STAGE(PG8_SB(1, 1), cB + hstep + kstep, voffB);
        PG8_WAIT_V(6); PG8_BAR;
    }
    for (;;) {
        const bool has_next = S.next(ui + 1, nxt);
        const char* nA = has_next ? (const char*)g.A + (size_t)nxt.pm * tstep : cA; const char* nB = has_next ? (const char*)g.Bt + (size_t)nxt.pn * tstep : cB;
        for (int t = 0; t < nt; t += 2) {
            const bool last = (t == nt - 2);
            const char* a1 = cA + (size_t)(t + 1) * kstep;
            const char* a2 = last ? nA : cA + (size_t)(t + 2) * kstep; const char* b2 = last ? nB : cB + (size_t)(t + 2) * kstep;
            const char* a3 = a2 + kstep; const char* b3 = b2 + kstep;
            if (last && has_next) S.a_ready(nxt);
            if constexpr (SP2) {
            PG8_LDB(B0, 0, 0); PG8_LDB(B1, 0, 1); PG8_SCHED; PG8_LDA(At, 0, 0); PG8_STAGE(PG8_SA(1, 1), a1 + hstep, voffA);
            PG8_WAIT_V(8); PG8_WAIT_L(0); PG8_BAR; PG8_MMA(0, 0, At, B0); PG8_MMA(0, 1, At, B1); PG8_BAR; PG8_SCHED;
            PG8_LDA(At, 0, 1); PG8_STAGE(PG8_SB(0, 0), b2, voffB); PG8_STAGE(PG8_SB(0, 1), b2 + hstep, voffB); PG8_STAGE(PG8_SA(0, 0), a2, voffA);
            PG8_WAIT_V(8); PG8_WAIT_L(0); PG8_BAR; PG8_MMA(1, 0, At, B0); PG8_MMA(1, 1, At, B1); PG8_BAR; PG8_SCHED;
            PG8_LDB(B0, 1, 0); PG8_LDB(B1, 1, 1); PG8_SCHED; PG8_LDA(At, 1, 0); PG8_STAGE(PG8_SA(0, 1), a2 + hstep, voffA);
            PG8_WAIT_V(8); PG8_WAIT_L(0); PG8_BAR; PG8_MMA(0, 0, At, B0); PG8_MMA(0, 1, At, B1); PG8_BAR; PG8_SCHED;
            PG8_LDA(At, 1, 1); PG8_STAGE(PG8_SB(1, 0), b3, voffB); PG8_STAGE(PG8_SB(1, 1), b3 + hstep, voffB); PG8_STAGE(PG8_SA(1, 0), a3, voffA);
            PG8_WAIT_V(8); PG8_WAIT_L(0); PG8_BAR; PG8_MMA(1, 0, At, B0); PG8_MMA(1, 1, At, B1); PG8_BAR; PG8_SCHED;
            } else {
            PG8_LDB(B0, 0, 0); PG8_SCHED; PG8_LDA(At, 0, 0); PG8_STAGE(PG8_SA(1, 1), a1 + hstep, voffA);
            PG8_WAIT_L(8); PG8_BAR; PG8_WAIT_L(0); PG8_MMA(0, 0, At, B0); PG8_BAR; PG8_SCHED;
            PG8_LDB(B1, 0, 1); PG8_STAGE(PG8_SB(0, 0), b2, voffB);
            PG8_BAR; PG8_WAIT_L(0); PG8_MMA(0, 1, At, B1); PG8_BAR;
            PG8_LDA(At, 0, 1); PG8_STAGE(PG8_SA(0, 0), a2, voffA);
            PG8_BAR; PG8_WAIT_L(0); PG8_MMA(1, 0, At, B0); PG8_BAR; PG8_SCHED;
            PG8_STAGE(PG8_SB(0, 1), b2 + hstep, voffB);
            PG8_WAIT_V(6); PG8_BAR; PG8_MMA(1, 1, At, B1); PG8_BAR;
            PG8_LDB(B0, 1, 0); PG8_SCHED; PG8_LDA(At, 1, 0); PG8_STAGE(PG8_SA(0, 1), a2 + hstep, voffA);
            PG8_WAIT_L(8); PG8_BAR; PG8_WAIT_L(0); PG8_MMA(0, 0, At, B0); PG8_BAR; PG8_SCHED;
            PG8_LDB(B1, 1, 1); PG8_STAGE(PG8_SB(1, 0), b3, voffB);
            PG8_BAR; PG8_WAIT_L(0); PG8_MMA(0, 1, At, B1); PG8_BAR;
            PG8_LDA(At, 1, 1); PG8_STAGE(PG8_SA(1, 0), a3, voffA);
            PG8_BAR; PG8_WAIT_L(0); PG8_MMA(1, 0, At, B0); PG8_BAR; PG8_SCHED;
            PG8_STAGE(PG8_SB(1, 1), b3 + hstep, voffB);
            PG8_WAIT_V(6); PG8_BAR; PG8_MMA(1, 1, At, B1); PG8_BAR;
            }
        }
        if constexpr (ALIGN_EPI) { if (wr == 0) PG8_BAR; }
        if constexpr (!Epi::AFTER_DRAIN) { E(acc, cur, wr, wc, fr, fq); S.done(cur); }
        if (!has_next) break;
#pragma unroll
        for (int a = 0; a < 2; ++a)
#pragma unroll
            for (int b = 0; b < 2; ++b)
#pragma unroll
                for (int m = 0; m < 4; ++m)
#pragma unroll
                    for (int n = 0; n < 2; ++n) acc[a][b][m][n] = (f32x4){0.f, 0.f, 0.f, 0.f};
        cur = nxt; cA = nA; cB = nB; ++ui;
        if constexpr (ALIGN_EPI) { if (wr == 1) PG8_BAR; }
    }
    PG8_WAIT_V(0);
    if constexpr (!ALIGN_EPI) { if (wr == 0) PG8_BAR; }
    PG8_BAR;
    if constexpr (Epi::AFTER_DRAIN) { E.fused(acc, cur, wr, wc, fr, fq, lds, wid, lane); S.done(cur); }
#undef PG8_SA
#undef PG8_SB
#undef PG8_STAGE
#undef PG8_LDA
#undef PG8_LDB
#undef PG8_MMA
#undef PG8_WAIT_V
#undef PG8_WAIT_L
#undef PG8_BAR
#undef PG8_SCHED
}
}
#ifndef PG8_SP2
#define PG8_SP2 true
#endif
#ifndef PG8_ALIGN
#define PG8_ALIGN true
#endif
#include <hip/hip_bf16.h>
#include <cmath>
namespace attn_body {
using bf16=__hip_bfloat16;
using bf16x8=__attribute__((ext_vector_type(8)))short;
using s16x4=__attribute__((ext_vector_type(4)))short;
using f32x16=__attribute__((ext_vector_type(16)))float;
using u32x4=__attribute__((ext_vector_type(4)))unsigned;
constexpr int BATCH=16,NHEAD=8,GQA=4,SEQ=2048,D=64;
constexpr int QP=512,KP=128,GP=512,OP=1024;
constexpr int NW=8,QBLK=32,QB=QBLK*NW,KVBLK=64,NQB=SEQ/QB;
__device__ __forceinline__ int crow(int r,int hi){return (r&3)+8*(r>>2)+4*hi;}
#define SBAR() __builtin_amdgcn_sched_barrier(0)
constexpr int NSLOT=3, SLOTB=8192;
constexpr int LDS_K=0, LDS_V=NSLOT*SLOTB, LDS_WS=2*NSLOT*SLOTB, LDS_OST=LDS_WS+NW*64*4, LDS_BYTES=LDS_OST+NW*4096;
constexpr float C2=0.125f*1.4426950408889634f;
__device__ __forceinline__ void glds16(const void*gsrc,unsigned lds_dst){unsigned keep;
  asm volatile("s_mov_b32 %0, m0\n\ts_mov_b32 m0, %2\n\ts_nop 0\n\tglobal_load_lds_dwordx4 %1, off\n\ts_mov_b32 m0, %0":"=&s"(keep):"v"(gsrc),"s"(lds_dst):"memory");}
__device__ __forceinline__ float max3f(float a,float b,float c){float r;asm("v_max3_f32 %0, %1, %2, %3":"=v"(r):"v"(a),"v"(b),"v"(c));return r;}
__device__ __forceinline__ float max2f(float a,float b){float r;asm("v_max_f32_e32 %0, %1, %2":"=v"(r):"v"(a),"v"(b));return r;}
__device__ __forceinline__ float fadd_s(float a,float b){float r;asm("v_add_f32_e32 %0, %1, %2":"=v"(r):"v"(a),"v"(b));return r;}
__device__ __forceinline__ float fsub_s(float a,float b){float r;asm("v_sub_f32_e32 %0, %1, %2":"=v"(r):"v"(a),"v"(b));return r;}
typedef float f32x2_t __attribute__((ext_vector_type(2))); typedef __bf16 bf16x2_t __attribute__((ext_vector_type(2)));
__device__ __forceinline__ unsigned cvtpk_s(float lo,float hi){f32x2_t v={lo,hi};bf16x2_t b=__builtin_convertvector(v,bf16x2_t);return __builtin_bit_cast(unsigned,b);}
#define WAIT_BAR(N) asm volatile("s_waitcnt vmcnt(" #N ") lgkmcnt(0)\n\ts_barrier":::"memory")

__device__ __forceinline__ void qkt(f32x16&p0,f32x16&p1,const char*Kslot,const bf16x8*qr,const f32x16&negm,int r32,int hi){
  const char*kb=Kslot+hi*1024+r32*16;
  #pragma unroll
  for(int d0=0;d0<4;++d0){
    const bf16x8 b0=*reinterpret_cast<const bf16x8*>(kb+d0*2048);
    const bf16x8 b1=*reinterpret_cast<const bf16x8*>(kb+d0*2048+512);
    if(d0==0){p0=__builtin_amdgcn_mfma_f32_32x32x16_bf16(b0,qr[0],negm,0,0,0);p1=__builtin_amdgcn_mfma_f32_32x32x16_bf16(b1,qr[0],negm,0,0,0);}
    else{p0=__builtin_amdgcn_mfma_f32_32x32x16_bf16(b0,qr[d0],p0,0,0,0);p1=__builtin_amdgcn_mfma_f32_32x32x16_bf16(b1,qr[d0],p1,0,0,0);}}
}
typedef __attribute__((address_space(3))) const char* lds_cptr;
typedef short v4i16_t __attribute__((ext_vector_type(4)));
__device__ __forceinline__ void kload8(bf16x8*kf,lds_cptr kp){
  kf[0]=*(const __attribute__((address_space(3))) bf16x8*)(kp);      kf[1]=*(const __attribute__((address_space(3))) bf16x8*)(kp+512);
  kf[2]=*(const __attribute__((address_space(3))) bf16x8*)(kp+2048); kf[3]=*(const __attribute__((address_space(3))) bf16x8*)(kp+2560);
  kf[4]=*(const __attribute__((address_space(3))) bf16x8*)(kp+4096); kf[5]=*(const __attribute__((address_space(3))) bf16x8*)(kp+4608);
  kf[6]=*(const __attribute__((address_space(3))) bf16x8*)(kp+6144); kf[7]=*(const __attribute__((address_space(3))) bf16x8*)(kp+6656);
}
__device__ __forceinline__ void kload2(bf16x8*kf,lds_cptr kp,int j){ kf[2*j]=*(const __attribute__((address_space(3))) bf16x8*)(kp+j*2048); kf[2*j+1]=*(const __attribute__((address_space(3))) bf16x8*)(kp+j*2048+512); }
__device__ __forceinline__ s16x4 vtr(lds_cptr p){ return __builtin_bit_cast(s16x4,__builtin_amdgcn_ds_read_tr16_b64_v4i16((__attribute__((address_space(3))) v4i16_t*)p)); }
__device__ __forceinline__ float rowmax(const f32x16&p0,const f32x16&p1){
  float a=max3f(p0[0],p0[1],p1[0]),b=max3f(p0[2],p0[3],p1[1]);a=max3f(a,p1[2],p1[3]);
  #pragma unroll
  for(int r=4;r<16;r+=4){a=max3f(a,p0[r],p0[r+1]);b=max3f(b,p0[r+2],p0[r+3]);a=max3f(a,p1[r],p1[r+1]);b=max3f(b,p1[r+2],p1[r+3]);}
  const float m=max2f(a,b);
  auto rr=__builtin_amdgcn_permlane32_swap(__float_as_uint(m),__float_as_uint(m),false,false);
  return max2f(__uint_as_float(rr[0]),__uint_as_float(rr[1]));
}
__device__ __forceinline__ void pv(f32x16*o,int vb,bf16x8 pa0,bf16x8 pa1,bf16x8 pa2,bf16x8 pa3){
  #pragma unroll
  for(int d0=0;d0<2;++d0){s16x4 lo[4],hi[4];
    #pragma unroll
    for(int ks=0;ks<4;++ks){
      asm volatile("ds_read_b64_tr_b16 %0,%1 offset:%c2":"=&v"(lo[ks]):"v"(vb),"i"(d0*4096+ks*1024):"memory");
      asm volatile("ds_read_b64_tr_b16 %0,%1 offset:%c2":"=&v"(hi[ks]):"v"(vb),"i"(d0*4096+ks*1024+512):"memory");}
    asm volatile("s_waitcnt lgkmcnt(0)":::"memory");SBAR();
    #define PK(k) (bf16x8){lo[k][0],lo[k][1],lo[k][2],lo[k][3],hi[k][0],hi[k][1],hi[k][2],hi[k][3]}
    o[d0]=__builtin_amdgcn_mfma_f32_32x32x16_bf16(pa0,PK(0),o[d0],0,0,0);
    o[d0]=__builtin_amdgcn_mfma_f32_32x32x16_bf16(pa1,PK(1),o[d0],0,0,0);
    o[d0]=__builtin_amdgcn_mfma_f32_32x32x16_bf16(pa2,PK(2),o[d0],0,0,0);
    o[d0]=__builtin_amdgcn_mfma_f32_32x32x16_bf16(pa3,PK(3),o[d0],0,0,0);
    #undef PK
  }
}
#ifndef ATTN_STORE16
#define ATTN_STORE16(p,v) (*(u32x4*)(p)=(v))
#endif
template<int THRL> __device__ __forceinline__ void attn_unit(int b,int h,int qb,const bf16*Q,const bf16*__restrict__ K,const bf16*__restrict__ V,const bf16*__restrict__ G,bf16*O,char*shm){
  const int tid=threadIdx.x,lane=tid&63,r32=lane&31,hi=lane>>5; const int wid=__builtin_amdgcn_readfirstlane(tid>>6);
  const long rowbase=(long)b*SEQ; const int q0=qb*QB;
  const bf16*Qw=Q+(rowbase+q0+wid*QBLK)*QP+h*D; const int kvh=h/GQA;
  const bf16*Kh=K+rowbase*KP+kvh*D,*Vh=V+rowbase*KP+kvh*D;
  const unsigned lds0=(unsigned)(uintptr_t)shm;
  float*wsf=(float*)(shm+LDS_WS)+wid*64;
  const bf16*ksrc=Kh+(long)lane*KP+wid*8;
  const bf16*vsrc=Vh+(long)(16*(wid&3)+(lane>>2))*KP+(wid>>2)*32+(lane&3)*8;
  const unsigned kdst=lds0+LDS_K+wid*1024, vdst=lds0+LDS_V+wid*1024;
  #define DMA_K(t,slot) glds16(ksrc+(long)(t)*KVBLK*KP,(unsigned)__builtin_amdgcn_readfirstlane(kdst+(slot)))
  #define DMA_V(t,slot) glds16(vsrc+(long)(t)*KVBLK*KP,(unsigned)__builtin_amdgcn_readfirstlane(vdst+(slot)))
  const int vb0=(int)(lds0+LDS_V)+((lane>>4)&1)*32+(lane&3)*8+(4*hi+((lane&15)>>2))*64;
  const char*Kbase=shm+LDS_K; bf16x8 kf[8];
  const lds_cptr shm3=(lds_cptr)shm; const lds_cptr kp0=shm3+LDS_K+hi*1024+r32*16; const lds_cptr vp0=shm3+LDS_V+((lane>>4)&1)*32+(lane&3)*8+(4*hi+((lane&15)>>2))*64;
  constexpr int NT=SEQ/KVBLK;
  DMA_K(0,0);DMA_V(0,0);DMA_K(1,SLOTB);
  bf16x8 qr[4];
  #pragma unroll
  for(int d0=0;d0<4;++d0)qr[d0]=*reinterpret_cast<const bf16x8*>(&Qw[(long)r32*QP+d0*16+hi*8]);
  float mhat=0.f,l_reg=0.f;f32x16 o[2];o[0]=f32x16{};o[1]=f32x16{};f32x16 negm=f32x16{};asm volatile("":"+v"(negm));
  #define CMASK(P0,P1,t) do{}while(0)
  bool resc=false;
  #define START(P0,P1) do{ const float rm=rowmax(P0,P1); resc=false; \
    { const float dl=rm; mhat=fadd_s(mhat,dl); \
      _Pragma("unroll") for(int r=0;r<16;++r){P0[r]=fsub_s(P0[r],dl);P1[r]=fsub_s(P1[r],dl);} \
      _Pragma("unroll") for(int r=0;r<16;++r)negm[r]=-mhat; asm volatile("":"+v"(negm)); } \
    _Pragma("unroll") for(int r=0;r<16;++r)P0[r]=__builtin_amdgcn_exp2f(P0[r]); }while(0)
  #define RESC() do{ if(resc){ asm volatile("s_waitcnt lgkmcnt(0)":::"memory"); \
      _Pragma("unroll") for(int d_=0;d_<2;++d_) _Pragma("unroll") for(int r=0;r<16;++r)o[d_][r]*=wsf[crow(r,hi)]; } }while(0)
  f32x16 pA0,pA1,pB0,pB1;
  int sl_prev=0,sl_cur=0,sl_next=SLOTB;
  #define ROT() do{sl_prev=sl_cur;sl_cur=sl_next;sl_next=(sl_next==(NSLOT-1)*SLOTB)?0:sl_next+SLOTB;}while(0)
  DMA_K(2,2*SLOTB);
  WAIT_BAR(3);
  qkt(pA0,pA1,Kbase,qr,negm,r32,hi);asm volatile("s_nop 15\n\ts_nop 7":"+v"(pA0),"+v"(pA1));CMASK(pA0,pA1,0);
  START(pA0,pA1);
  _Pragma("unroll") for(int r=0;r<16;++r)pA1[r]=__builtin_amdgcn_exp2f(pA1[r]);
  WAIT_BAR(0);
  DMA_K(3,0);DMA_V(1,SLOTB);
  ROT();
  kload8(kf,kp0+sl_cur);
  WAIT_BAR(2);
  s16x4 vlo[8],vhi[8]; u32x4 pw0,pw1,pw2,pw3;
  #define PKW(P,B) cvtpk_s(P[B],P[B+1])
  #define PAF(k) __builtin_bit_cast(bf16x8,pw##k)
  #define VFR(i) (bf16x8){vlo[i][0],vlo[i][1],vlo[i][2],vlo[i][3],vhi[i][0],vhi[i][1],vhi[i][2],vhi[i][3]}
  #define PIN(x) asm volatile("":"+v"(x))
  #define MX3(a,b,c) __builtin_fmaxf(__builtin_fmaxf((a),(b)),(c))
  #define GAPA(MF,A0,A1,A2,A3,W0,W1,PW) do{ MF; sacc+=A0; sacc+=A1; sacc+=A2; sacc+=A3; PIN(sacc); W0; W1; PIN(PW); SBAR(); }while(0)
  #define EX(v) __builtin_amdgcn_exp2f(v)
  #define GAPB(MF,X,B) do{ MF; X[B]=EX(X[B]); X[B+1]=EX(X[B+1]); X[B+2]=EX(X[B+2]); X[B+3]=EX(X[B+3]); PIN(X); SBAR(); }while(0)
  #define VRD(i) do{ vlo[i]=vtr(vp_+(((i)>>2)*4096+((i)&3)*1024)); vhi[i]=vtr(vp_+(((i)>>2)*4096+((i)&3)*1024+512)); }while(0)
  #define KRD(G,j) do{ if(G){ kload2(kf,kp0+sl_next,j); SBAR(); } }while(0)
  #define STEP(C0,C1,P0,P1,t,GK,GV,GL) do{ SBAR(); \
    const lds_cptr vp_=vp0+sl_prev; \
    VRD(0); SBAR(); float sacc=(P0[0]+P0[1]); \
    GAPA(C0=__builtin_amdgcn_mfma_f32_32x32x16_bf16(kf[0],qr[0],negm,0,0,0), P0[2],P0[3],P0[4],P0[5],     pw0[0]=PKW(P0,0), pw0[1]=PKW(P0,2), pw0); \
    VRD(4); SBAR(); GAPA(C1=__builtin_amdgcn_mfma_f32_32x32x16_bf16(kf[1],qr[0],negm,0,0,0), P0[6],P0[7],P0[8],P0[9],     pw0[2]=PKW(P0,4), pw0[3]=PKW(P0,6), pw0); \
    VRD(1); SBAR(); GAPA(C0=__builtin_amdgcn_mfma_f32_32x32x16_bf16(kf[2],qr[1],C0,0,0,0),   P0[10],P0[11],P0[12],P0[13], pw1[0]=PKW(P0,8), pw1[1]=PKW(P0,10), pw1); \
    VRD(5); SBAR(); GAPA(C1=__builtin_amdgcn_mfma_f32_32x32x16_bf16(kf[3],qr[1],C1,0,0,0),   P0[14],P0[15],P1[0],P1[1],   pw1[2]=PKW(P0,12),pw1[3]=PKW(P0,14), pw1); \
    VRD(2); SBAR(); GAPA(C0=__builtin_amdgcn_mfma_f32_32x32x16_bf16(kf[4],qr[2],C0,0,0,0),   P1[2],P1[3],P1[4],P1[5],     pw2[0]=PKW(P1,0), pw2[1]=PKW(P1,2), pw2); \
    VRD(6); SBAR(); GAPA(C1=__builtin_amdgcn_mfma_f32_32x32x16_bf16(kf[5],qr[2],C1,0,0,0),   P1[6],P1[7],P1[8],P1[9],     pw2[2]=PKW(P1,4), pw2[3]=PKW(P1,6), pw2); \
    VRD(3); SBAR(); GAPA(C0=__builtin_amdgcn_mfma_f32_32x32x16_bf16(kf[6],qr[3],C0,0,0,0),   P1[10],P1[11],P1[12],P1[13], pw3[0]=PKW(P1,8), pw3[1]=PKW(P1,10), pw3); \
    VRD(7); SBAR(); GAPA(C1=__builtin_amdgcn_mfma_f32_32x32x16_bf16(kf[7],qr[3],C1,0,0,0),   P1[14],P1[15],0.f,0.f,       pw3[2]=PKW(P1,12),pw3[3]=PKW(P1,14), pw3); \
    l_reg+=sacc; \
    if(GK){DMA_K((t)+3,sl_cur);} if(GV){DMA_V((t)+1,sl_next);} \
    CMASK(C0,C1,t); \
    { float a=MX3(C0[0],C0[1],C1[0]),b=MX3(C0[2],C0[3],C1[1]); a=MX3(a,C1[2],C1[3]); \
      _Pragma("unroll") for(int r=4;r<16;r+=4){a=MX3(a,C0[r],C0[r+1]);b=MX3(b,C0[r+2],C0[r+3]);a=MX3(a,C1[r],C1[r+1]);b=MX3(b,C1[r+2],C1[r+3]);} \
      float rm=__builtin_fmaxf(a,b); { auto rr=__builtin_amdgcn_permlane32_swap(__float_as_uint(rm),__float_as_uint(rm),false,false); rm=__builtin_fmaxf(__uint_as_float(rr[0]),__uint_as_float(rr[1])); } \
      resc=false; \
      if(__builtin_expect(__any(rm>(float)THRL),0)){ const float dl=__builtin_fmaxf(rm,0.f); mhat+=dl; \
        _Pragma("unroll") for(int r=0;r<16;++r){C0[r]-=dl;C1[r]-=dl;} \
        _Pragma("unroll") for(int r=0;r<16;++r)negm[r]=-mhat; asm volatile("":"+v"(negm)); \
        const float f=__builtin_amdgcn_exp2f(-dl); l_reg*=f; if(hi==0)wsf[r32]=f; resc=true; } } \
    SBAR(); \
    GAPB(o[0]=__builtin_amdgcn_mfma_f32_32x32x16_bf16(PAF(0),VFR(0),o[0],0,0,0), C0,0); \
    GAPB(o[1]=__builtin_amdgcn_mfma_f32_32x32x16_bf16(PAF(0),VFR(4),o[1],0,0,0), C0,4); \
    KRD(GL,0); GAPB(o[0]=__builtin_amdgcn_mfma_f32_32x32x16_bf16(PAF(1),VFR(1),o[0],0,0,0), C0,8); \
    KRD(GL,1); GAPB(o[1]=__builtin_amdgcn_mfma_f32_32x32x16_bf16(PAF(1),VFR(5),o[1],0,0,0), C0,12); \
    KRD(GL,2); GAPB(o[0]=__builtin_amdgcn_mfma_f32_32x32x16_bf16(PAF(2),VFR(2),o[0],0,0,0), C1,0); \
    KRD(GL,3); GAPB(o[1]=__builtin_amdgcn_mfma_f32_32x32x16_bf16(PAF(2),VFR(6),o[1],0,0,0), C1,4); \
    GAPB(o[0]=__builtin_amdgcn_mfma_f32_32x32x16_bf16(PAF(3),VFR(3),o[0],0,0,0), C1,8); \
    GAPB(o[1]=__builtin_amdgcn_mfma_f32_32x32x16_bf16(PAF(3),VFR(7),o[1],0,0,0), C1,12); \
    }while(0)
  int t=1;
  #undef CMASK
  #define CMASK(P0,P1,t) do{}while(0)
  for(;t+5<NT;t+=2){
    STEP(pB0,pB1,pA0,pA1,t,true,true,true);     WAIT_BAR(2); RESC(); ROT();
    STEP(pA0,pA1,pB0,pB1,t+1,true,true,true);   WAIT_BAR(2); RESC(); ROT();
  }
  #undef CMASK
  #define CMASK(P0,P1,t) do{}while(0)
  #define ENDW(tt) do{ if((tt)+3<NT){WAIT_BAR(2);} else if((tt)+2<NT){WAIT_BAR(1);} else {WAIT_BAR(0);} }while(0)
  for(;t+1<NT;t+=2){
    STEP(pB0,pB1,pA0,pA1,t,(t+3<NT),(t+1<NT),(t+1<NT));       ENDW(t);   RESC(); ROT();
    STEP(pA0,pA1,pB0,pB1,t+1,(t+4<NT),(t+2<NT),(t+2<NT));     ENDW(t+1); RESC(); ROT();
  }
  STEP(pB0,pB1,pA0,pA1,NT-1,false,false,false); RESC();
  { float sacc=pB0[0]+pB0[1]; _Pragma("unroll") for(int r=2;r<16;++r)sacc+=pB0[r]; _Pragma("unroll") for(int r=0;r<16;++r)sacc+=pB1[r]; l_reg+=sacc;
    pw0=(u32x4){PKW(pB0,0),PKW(pB0,2),PKW(pB0,4),PKW(pB0,6)};pw1=(u32x4){PKW(pB0,8),PKW(pB0,10),PKW(pB0,12),PKW(pB0,14)};pw2=(u32x4){PKW(pB1,0),PKW(pB1,2),PKW(pB1,4),PKW(pB1,6)};pw3=(u32x4){PKW(pB1,8),PKW(pB1,10),PKW(pB1,12),PKW(pB1,14)};
    SBAR(); pv(o,vb0+sl_cur,PAF(0),PAF(1),PAF(2),PAF(3)); }
  #undef PKW
  #undef PAF
  #undef VFR
  #undef PIN
  #undef MX3
  #undef GAPA
  #undef GAPB
  #undef EX
  #undef VRD
  #undef KRD
  #undef STEP
  #undef ENDW
  {auto rr=__builtin_amdgcn_permlane32_swap(__float_as_uint(l_reg),__float_as_uint(l_reg),false,false);l_reg=__uint_as_float(rr[0])+__uint_as_float(rr[1]);}
  if(hi==0)wsf[32+r32]=l_reg;asm volatile("s_waitcnt lgkmcnt(0)":::"memory");
  float rli[16];
  #pragma unroll
  for(int r=0;r<16;++r)rli[r]=__builtin_amdgcn_rcpf(wsf[32+crow(r,hi)]);
  bf16*Ow=O+(rowbase+q0+wid*QBLK)*OP+h*D; const bf16*Gw=G+(rowbase+q0+wid*QBLK)*GP+h*D;
  { bf16*stg=(bf16*)(shm+LDS_OST)+wid*2048;
    #pragma unroll
    for(int r=0;r<16;++r){const int orow=crow(r,hi);
      #pragma unroll
      for(int d0=0;d0<2;++d0)stg[orow*64+d0*32+r32]=__float2bfloat16(o[d0][r]*rli[r]);}
    asm volatile("s_waitcnt lgkmcnt(0)":::"memory");
    #pragma unroll
    for(int i=0;i<4;++i){const int row=i*8+(lane>>3),ch=lane&7; const u32x4 v=*(const u32x4*)(stg+row*64+ch*8); const u32x4 g=*(const u32x4*)(Gw+(long)row*GP+ch*8); u32x4 w;
      #pragma unroll
      for(int e=0;e<4;++e){ const float a0=__uint_as_float(v[e]<<16)*__uint_as_float(g[e]<<16), a1=__uint_as_float(v[e]&0xffff0000u)*__uint_as_float(g[e]&0xffff0000u); w[e]=cvtpk_s(a0,a1);}
      ATTN_STORE16(Ow+(long)row*OP+ch*8,w);} }
  asm volatile("s_waitcnt lgkmcnt(0)\n\ts_barrier":::"memory");
  #undef DMA_K
  #undef DMA_V
  #undef CMASK
  #undef START
  #undef RESC
  #undef ROT
}
constexpr int ATTN_LDS_BYTES=LDS_BYTES;
struct AttnTensors { const bf16* Q; const bf16* K; const bf16* V; const bf16* G; bf16* O; };
struct AttnUnit { int bh; int qb; };
struct StaticOrder {
  int vcu, upc;
  __device__ __forceinline__ explicit StaticOrder(int grid,int block):vcu((grid%8==0)?(block%8)*(grid/8)+block/8:block),upc((BATCH*NHEAD*NQB+grid-1)/grid){}
  __device__ __forceinline__ bool next(int i,AttnUnit&u)const{ if(i>=upc)return false; const int x=vcu*upc+i; if(x>=BATCH*NHEAD*NQB)return false; u.qb=x%NQB; u.bh=x/NQB; return true; }
  __device__ __forceinline__ void a_ready(const AttnUnit&)const{}
  __device__ __forceinline__ void done(const AttnUnit&)const{}
};
template<class Sched,int THRL=8> __device__ __forceinline__ void attn_phase(char*lds,const AttnTensors&T,const Sched&S){
  AttnUnit u;
  for(int i=0;S.next(i,u);++i){ S.a_ready(u); attn_unit<THRL>(u.bh/NHEAD,u.bh%NHEAD,u.qb,T.Q,T.K,T.V,T.G,T.O,lds); S.done(u); }
}
#undef SBAR
#undef WAIT_BAR
}
constexpr int NWAVES = 8;
#ifndef MK_N_LAUNCHES
#define MK_N_LAUNCHES 1
#endif
constexpr int PER_PHASE = 7;
constexpr int N_LAUNCHES = MK_N_LAUNCHES;
static_assert(N_LAUNCHES == 1 || N_LAUNCHES == PER_PHASE, "MK_N_LAUNCHES is 1 or 7");

constexpr int BATCH = 16, T = 2048, D = 1024, HD = 64;
constexpr int M = BATCH * T;
constexpr int NIN = 3456, NINP = 3584;
constexpr int RW = 512, RSW = 1664;
constexpr float NORM_EPS = 1e-6f, GN_EPS = 64e-5f, L2_EPS = 1e-12f, DECAY_SCALE = 0.6065306597126334f;

constexpr size_t MiB = 1u << 20;
constexpr size_t WS_CTL = 0, CTL_ZERO_BYTES = 1 * MiB;
constexpr size_t WS_MOD = 512 * 1024;
constexpr size_t WS_ROPE = 1 * MiB;
constexpr size_t WS_WIN = 2 * MiB;
constexpr size_t WS_WOUT = 10 * MiB;
constexpr size_t WS_XCH = 12 * MiB;
constexpr size_t WS_BON = 14 * MiB;
constexpr size_t WS_XN = 16 * MiB;
constexpr size_t WS_Q = 80 * MiB, WS_K = 112 * MiB, WS_V = 120 * MiB;
constexpr size_t WS_GATT = 128 * MiB;
constexpr size_t WS_RKV = 160 * MiB;
constexpr size_t WS_WA = 256 * MiB;
constexpr size_t WS_GRW = 264 * MiB;
constexpr size_t WS_Y = 296 * MiB;
constexpr size_t WS_OUTPRE = 80 * MiB;
constexpr size_t WS_TWG = 424 * MiB, WS_ADG = 428 * MiB;
constexpr size_t WS_END = 432 * MiB;
constexpr int CW_TMO = 0, CW_CODE = 1, CW_PRE = 2048;
constexpr int CW_BAR = 4096;
constexpr int CW_SEAM = 16384;

constexpr int RING_OFF = 0, RING_BYTES = 143360;
constexpr int LDSCTL_OFF = RING_BYTES, MISC_OFF = LDSCTL_OFF + 320;
constexpr int LDS_BYTES = 147456;
static_assert(MISC_OFF + 128 <= LDS_BYTES, "LDS map");
#define GAS __attribute__((address_space(1)))
#define LAS __attribute__((address_space(3)))
typedef unsigned short bf16;
typedef unsigned v4u __attribute__((ext_vector_type(4)));
typedef float f32x4 __attribute__((ext_vector_type(4)));
typedef short bf16x8 __attribute__((ext_vector_type(8)));
typedef GAS unsigned gu32;
typedef GAS unsigned long long gu64;
#define RLX_AGENT __ATOMIC_RELAXED, __HIP_MEMORY_SCOPE_AGENT
#define LDS_WAIT() asm volatile("s_waitcnt lgkmcnt(0)" ::: "memory")
#define VM_WAIT() asm volatile("s_waitcnt vmcnt(0)" ::: "memory")
__device__ __forceinline__ unsigned long long rt() { return __builtin_amdgcn_s_memrealtime(); }
__device__ __forceinline__ unsigned f2bf(float f) { unsigned u = __builtin_bit_cast(unsigned, f); return (u + 0x7fffu + ((u >> 16) & 1u)) >> 16; }
__device__ __forceinline__ unsigned pk2(float lo, float hi) { return f2bf(lo) | (f2bf(hi) << 16); }

#define XB_TMO      128
#define XB_XCNT(j)  (256  + 64 * (j))
#define XB_XSUB(j)  (1280 + 64 * (j))
#define XB_XGEN(j)  (2304 + 64 * (j))
#define XB_TOP      3328
#define XB_TOPGEN   3392
#define XCD_BAR_WORDS 3456
#define XB_SPIN_CAP (1u << 18)

__device__ __forceinline__ unsigned xb_ld(unsigned* p)              { return __hip_atomic_load(p, __ATOMIC_RELAXED, __HIP_MEMORY_SCOPE_AGENT); }
__device__ __forceinline__ unsigned xb_add(unsigned* p, unsigned v) { return __hip_atomic_fetch_add(p, v, __ATOMIC_RELAXED, __HIP_MEMORY_SCOPE_AGENT); }
__device__ __forceinline__ unsigned xb_xcc_id() { return (unsigned)__builtin_amdgcn_s_getreg((3 << 11) | 20) & 0xFu; }
#define XB_SPIN(cond, bar) do { unsigned _sp = 0; while (cond) { __builtin_amdgcn_s_sleep(1); \
    if ((++_sp & 255u) == 0u) { if (xb_ld(&(bar)[XB_TMO])) break; if (_sp > XB_SPIN_CAP) { atomicAdd(&(bar)[XB_TMO], 1u); break; } } } } while (0)

struct XcdBarrier {
    unsigned* bar; unsigned x;
    volatile LAS unsigned* st;
};

__device__ __forceinline__ XcdBarrier xcd_barrier_post(unsigned* bar, volatile LAS unsigned* st) {
    XcdBarrier b; b.bar = bar; b.x = xb_xcc_id(); b.st = st;
    if (threadIdx.x == 0) (void)xb_add(&bar[XB_XCNT(b.x)], 1u);
    return b;
}
__device__ __forceinline__ void xcd_barrier_complete(unsigned* bar, unsigned x, unsigned& nloc, unsigned& nx) {
    const unsigned G = gridDim.x * gridDim.y * gridDim.z;
    unsigned sum, cnt, mine, sp = 0u;
    for (;;) {
        sum = 0u; cnt = 0u; mine = 0u;
#pragma unroll
        for (unsigned j = 0; j < 16; ++j) { const unsigned c = xb_ld(&bar[XB_XCNT(j)]); sum += c; cnt += (c > 0u) ? 1u : 0u; mine = (j == x) ? c : mine; }
        if (sum == G) break;
        __builtin_amdgcn_s_sleep(1);
        if ((++sp & 255u) == 0u) { if (xb_ld(&bar[XB_TMO])) break; if (sp > XB_SPIN_CAP) { atomicAdd(&bar[XB_TMO], 1u); break; } }
    }
    nloc = mine > 0u ? mine : 1u; nx = cnt > 0u ? cnt : 1u;
}

__device__ __forceinline__ void xcd_barrier(const XcdBarrier& b) {
    asm volatile("s_waitcnt vmcnt(0)" ::: "memory");
    __syncthreads();
    if (threadIdx.x == 0) {
        unsigned* bar = b.bar;
        __builtin_amdgcn_s_waitcnt(0);
        unsigned nloc = b.st[0], nx = b.st[1];
        if (nloc == 0u) { xcd_barrier_complete(bar, b.x, nloc, nx); b.st[0] = nloc; b.st[1] = nx; }
        const unsigned old = xb_add(&bar[XB_XSUB(b.x)], 1u);
        const unsigned gen = old / nloc;
        if (old + 1u == (gen + 1u) * nloc) {
            __builtin_amdgcn_fence(__ATOMIC_RELEASE, "agent");
            asm volatile("s_waitcnt vmcnt(0)" ::: "memory");
            const unsigned og = xb_add(&bar[XB_TOP], 1u);
            const unsigned tg = og / nx;
            if (og + 1u == (tg + 1u) * nx) xb_add(&bar[XB_TOPGEN], 1u);
            else XB_SPIN(xb_ld(&bar[XB_TOPGEN]) == tg, bar);
            __builtin_amdgcn_fence(__ATOMIC_ACQUIRE, "agent");
            xb_add(&bar[XB_XGEN(b.x)], 1u);
            asm volatile("s_waitcnt vmcnt(0)" ::: "memory");
        } else {
            XB_SPIN(xb_ld(&bar[XB_XGEN(b.x)]) == gen, bar);
            __builtin_amdgcn_fence(__ATOMIC_ACQUIRE, "agent");
            asm volatile("s_waitcnt vmcnt(0)" ::: "memory");
        }
    }
    __syncthreads();
}
#define CAS __attribute__((address_space(4)))
struct Frame {
    LAS unsigned char* lds;
    volatile LAS unsigned* MISC;
    gu32* ctl;
    int tid, lane, wave;
    int vcu, G;
    const CAS char* kp;
};
struct Ptrs {
    const float *x, *c, *w_ada, *b_ada, *g_pre, *w_in, *q_norm_g, *k_norm_g, *taps, *w_up, *w0, *a_up, *a0, *k_k, *k_a, *r_k, *gn_w, *gn_b, *w_out, *g_post;
    float* out;
    float *MOD, *ROPE, *BON, *Y, *OUTPRE;
    bf16 *Win_t, *Wout_t, *XN, *QB, *KB, *VB, *GATT, *RKV, *WA, *GRW, *MIX, *TWG, *ADG;
};
__device__ __forceinline__ Ptrs load_ptrs(const Frame& F) {
    const CAS char* kp = F.kp; asm volatile("" : "+s"(kp));
    const float* const CAS* in = (const float* const CAS*)kp;
    Ptrs P;
    P.x = in[0]; P.c = in[1]; P.w_ada = in[2]; P.b_ada = in[3]; P.g_pre = in[4]; P.w_in = in[5]; P.q_norm_g = in[6]; P.k_norm_g = in[7];
    P.taps = in[8]; P.w_up = in[9]; P.w0 = in[10]; P.a_up = in[11]; P.a0 = in[12]; P.k_k = in[13]; P.k_a = in[14]; P.r_k = in[15];
    P.gn_w = in[16]; P.gn_b = in[17]; P.w_out = in[18]; P.g_post = in[19];
    P.out = *(float* const CAS*)(kp + 160); unsigned char* ws = *(unsigned char* const CAS*)(kp + 168);
    P.MOD = (float*)(ws + WS_MOD); P.ROPE = (float*)(ws + WS_ROPE); P.BON = (float*)(ws + WS_BON); P.Y = (float*)(ws + WS_Y); P.OUTPRE = (float*)(ws + WS_OUTPRE);
    P.Win_t = (bf16*)(ws + WS_WIN); P.Wout_t = (bf16*)(ws + WS_WOUT); P.XN = (bf16*)(ws + WS_XN); P.MIX = (bf16*)(ws + WS_XN);
    P.QB = (bf16*)(ws + WS_Q); P.KB = (bf16*)(ws + WS_K); P.VB = (bf16*)(ws + WS_V); P.GATT = (bf16*)(ws + WS_GATT); P.RKV = (bf16*)(ws + WS_RKV); P.WA = (bf16*)(ws + WS_WA); P.GRW = (bf16*)(ws + WS_GRW); P.TWG = (bf16*)(ws + WS_TWG); P.ADG = (bf16*)(ws + WS_ADG);
    return P;
}

__device__ __forceinline__ float wave_sum(float v) {
#pragma unroll
    for (int o = 1; o < 64; o <<= 1) v += __shfl_xor(v, o);
    return v;
}
__device__ __forceinline__ float bf2f(bf16 v) { return __uint_as_float((unsigned)v << 16); }
__device__ __forceinline__ float sigmoidf_(float v) { return 1.0f / (1.0f + __expf(-v)); }
__device__ __forceinline__ float siluf_(float v) { return v / (1.0f + __expf(-v)); }

__device__ __forceinline__ int win_dest_row(int n) {
    if (n < 640) {
        const int hd = n >> 6, d = n & 63, tile = hd >> 2, wc = hd & 3, bj = d >> 5, dl = d & 31, nn = dl >> 4, fq = (dl >> 2) & 3, e = dl & 3;
        return tile * 256 + 128 * bj + 32 * wc + 8 * fq + 4 * nn + e;
    }
    if (n < 768) { const int j = n - 640, vh = j >> 6, d = j & 63; return 2 * 256 + 128 * (d >> 5) + 32 * (2 + vh) + (d & 31); }
    if (n < 1280) return 3 * 256 + (n - 768);
    if (n < 2816) return 5 * 256 + (n - 1280);
    if (n < 2944) return 11 * 256 + (n - 2816);
    return 12 * 256 + (n - 2944);
}
template <bool PERMUTE>
__device__ __forceinline__ void p0_transpose_item(const float* W, int K, int N, bf16* WT, LAS float* scr, int item, int lane) {
    const int nblk = N / 32, kb = item / nblk, nb = item % nblk, k0 = 64 * kb, n0 = 32 * nb;
#pragma unroll 8
    for (int i = 0; i < 32; ++i) { const int kk = 2 * i + (lane >> 5); scr[kk * 33 + (lane & 31)] = W[(size_t)(k0 + kk) * N + n0 + (lane & 31)]; }
    LDS_WAIT(); asm volatile("" ::: "memory");
    const int c = lane & 7;
#pragma unroll
    for (int j = 0; j < 4; ++j) { const int n = (lane >> 3) + 8 * j; const LAS float* s = scr + (8 * c) * 33 + n;
        v4u o; o.x = pk2(s[0 * 33], s[1 * 33]); o.y = pk2(s[2 * 33], s[3 * 33]); o.z = pk2(s[4 * 33], s[5 * 33]); o.w = pk2(s[6 * 33], s[7 * 33]);
        const int drow = PERMUTE ? win_dest_row(n0 + n) : (n0 + n);
        *(GAS v4u*)(WT + (size_t)drow * K + k0 + 8 * c) = o; }
    LDS_WAIT(); asm volatile("" ::: "memory");
}
__device__ __forceinline__ void p0_mod_item(Frame& F, const Ptrs& P, LAS float* scr, int item) {
    const int cb = item >> 3, ks = item & 7, col = cb * 64 + F.lane, k0 = ks * 128;
    for (int i = F.lane; i < 16 * 128; i += 64) { const int b = i >> 7, k = i & 127; scr[i] = siluf_(P.c[b * D + k0 + k]); }
    LDS_WAIT(); asm volatile("" ::: "memory");
    float acc[16];
#pragma unroll
    for (int b = 0; b < 16; ++b) acc[b] = 0.f;
    for (int k = 0; k < 128; k += 4) {
        float w[4];
#pragma unroll
        for (int j = 0; j < 4; ++j) w[j] = P.w_ada[(size_t)(k0 + k + j) * (3 * D) + col];
#pragma unroll
        for (int b = 0; b < 16; ++b) { const f32x4 s = *(const LAS f32x4*)(scr + b * 128 + k); acc[b] += s[0] * w[0] + s[1] * w[1] + s[2] * w[2] + s[3] * w[3]; }
    }
    const float bias = (ks == 0) ? P.b_ada[col] : 0.f;
#pragma unroll
    for (int b = 0; b < 16; ++b) atomicAdd(P.MOD + b * (3 * D) + col, acc[b] + bias);
    LDS_WAIT(); asm volatile("" ::: "memory");
}
__device__ __forceinline__ void p0_prologue(Frame& F) {
    const Ptrs P = load_ptrs(F);
    LAS float* scr = (LAS float*)(F.lds + RING_OFF + F.wave * 16384);
    const int gw = F.vcu * NWAVES + F.wave, NGW = F.G * NWAVES;
    constexpr int I_IN = (D / 64) * (NIN / 32), I_OUT = (D / 64) * (D / 32), I_MOD = 48 * 8;
    constexpr int NITEMS = I_IN + I_OUT + I_MOD;
    for (int it0 = gw; it0 < NITEMS; it0 += NGW) {
        int r = NITEMS - 1 - it0;
        if (r >= I_IN + I_OUT) { p0_mod_item(F, P, scr, r - I_IN - I_OUT); continue; }
        if (r < I_IN) { p0_transpose_item<true>(P.w_in, D, NIN, P.Win_t, scr, r, F.lane); continue; } r -= I_IN;
        p0_transpose_item<false>(P.w_out, D, D, P.Wout_t, scr, r, F.lane);
    }
    { const int gt = F.vcu * (NWAVES * 64) + F.tid, NGT = F.G * NWAVES * 64;
      for (int i = gt; i < 16384; i += NGT) *(GAS v4u*)(P.Win_t + (size_t)(11 * 256 + 128) * D + (size_t)i * 8) = (v4u){0u, 0u, 0u, 0u};
      for (int i = gt; i < 1024; i += NGT) { const int pos = i >> 4, fi = i & 15; const float inv = powf(10000.0f, -(float)fi / 16.0f); const float ang = (float)pos * inv;
          P.ROPE[i] = cosf(ang); P.ROPE[1024 + i] = sinf(ang); } }
}
__device__ __forceinline__ void p1_xn(Frame& F) {
    const Ptrs P = load_ptrs(F);
    const int gw = F.vcu * NWAVES + F.wave, NGW = F.G * NWAVES;
    for (int grp = gw; grp < M / 16; grp += NGW) {
        const int m0 = grp * 16, b = m0 / T;
        f32x4 gs[4], sh[4];
#pragma unroll
        for (int j = 0; j < 4; ++j) { const int d0 = 256 * j + 4 * F.lane; const f32x4 g = *(const GAS f32x4*)(P.g_pre + d0), sc = *(const GAS f32x4*)(P.MOD + b * 3 * D + D + d0);
            gs[j] = g * (sc + 1.0f); sh[j] = *(const GAS f32x4*)(P.MOD + b * 3 * D + d0); }
        for (int r = 0; r < 16; ++r) {
            const GAS f32x4* xr = (const GAS f32x4*)(P.x + (size_t)(m0 + r) * D) + F.lane;
            f32x4 v[4]; float s = 0.f;
#pragma unroll
            for (int j = 0; j < 4; ++j) { v[j] = xr[64 * j]; s += (v[j].x * v[j].x + v[j].y * v[j].y) + (v[j].z * v[j].z + v[j].w * v[j].w); }
            const float rstd = 1.f / sqrtf(wave_sum(s) * (1.f / D) + NORM_EPS);
            GAS unsigned long long* o8 = (GAS unsigned long long*)(P.XN + (size_t)(m0 + r) * D) + F.lane;
#pragma unroll
            for (int j = 0; j < 4; ++j) { const f32x4 h = v[j] * rstd * gs[j] + sh[j];
                o8[64 * j] = (unsigned long long)pk2(h.x, h.y) | ((unsigned long long)pk2(h.z, h.w) << 32); }
        }
    }
}

struct EpiInProj {
    static constexpr bool PERM = true, AFTER_DRAIN = false;
    bf16 *Q, *K, *V, *GATT, *RKV, *WA, *GRW; const float *qg, *kg, *rope; float c2;
    __device__ __forceinline__ void operator()(const f32x4 (&acc)[2][2][4][2], const pg8::Unit& u, int wr, int wc, int fr, int fq) const {
        const int pn = u.pn, row0 = u.pm * 256 + wr * 64 + fr;
        if (pn >= 3) {
            bf16* base; int ldc, colt; bool act;
            if (pn < 5) { base = GATT; ldc = 512; colt = (pn - 3) * 256; act = true; }
            else if (pn < 11) { base = RKV; ldc = 1536; colt = (pn - 5) * 256; act = false; }
            else if (pn == 11) { base = WA; ldc = 128; colt = 0; act = false; }
            else { base = GRW; ldc = 512; colt = (pn - 12) * 256; act = true; }
            const int col0 = colt + wc * 32 + 8 * fq;
#pragma unroll
            for (int ai = 0; ai < 2; ++ai)
#pragma unroll
                for (int m = 0; m < 4; ++m) { bf16* rowp = base + (size_t)(row0 + ai * 128 + m * 16) * ldc + col0;
#pragma unroll
                    for (int bj = 0; bj < 2; ++bj) { if (pn == 11 && bj == 1) continue;
                        f32x4 v0 = acc[ai][bj][m][0], v1 = acc[ai][bj][m][1];
                        if (act) { v0 = (f32x4){siluf_(v0[0]), siluf_(v0[1]), siluf_(v0[2]), siluf_(v0[3])}; v1 = (f32x4){siluf_(v1[0]), siluf_(v1[1]), siluf_(v1[2]), siluf_(v1[3])}; }
                        v4u w; w.x = pg8::cvt_pk_bf16(v0[0], v0[1]); w.y = pg8::cvt_pk_bf16(v0[2], v0[3]); w.z = pg8::cvt_pk_bf16(v1[0], v1[1]); w.w = pg8::cvt_pk_bf16(v1[2], v1[3]);
                        *(v4u*)(rowp + bj * 128) = w; } }
        } else if (pn == 2 && wc >= 2) {
#pragma unroll
            for (int ai = 0; ai < 2; ++ai)
#pragma unroll
                for (int m = 0; m < 4; ++m) { bf16* rowp = V + (size_t)(row0 + ai * 128 + m * 16) * 128 + (wc - 2) * 64 + 8 * fq;
#pragma unroll
                    for (int bj = 0; bj < 2; ++bj) { const f32x4 v0 = acc[ai][bj][m][0], v1 = acc[ai][bj][m][1];
                        v4u w; w.x = pg8::cvt_pk_bf16(v0[0], v0[1]); w.y = pg8::cvt_pk_bf16(v0[2], v0[3]); w.z = pg8::cvt_pk_bf16(v1[0], v1[1]); w.w = pg8::cvt_pk_bf16(v1[2], v1[3]);
                        *(v4u*)(rowp + bj * 32) = w; } }
        } else {
            const bool isq = pn < 2; const float* g = isq ? qg : kg; const float sc = isq ? c2 : 1.0f;
            bf16* base = isq ? (Q + (pn * 4 + wc) * 64) : (K + wc * 64); const int ldc = isq ? 512 : 128;
            f32x4 gv[2][2];
#pragma unroll
            for (int bj = 0; bj < 2; ++bj)
#pragma unroll
                for (int n = 0; n < 2; ++n) gv[bj][n] = *(const f32x4*)(g + 32 * bj + 16 * n + 4 * fq);
#pragma unroll
            for (int ai = 0; ai < 2; ++ai)
#pragma unroll
                for (int m = 0; m < 4; ++m) { const int row = row0 + ai * 128 + m * 16, t = row & (T - 1);
                    float ss = 0.f;
#pragma unroll
                    for (int bj = 0; bj < 2; ++bj)
#pragma unroll
                        for (int n = 0; n < 2; ++n) { const f32x4 v = acc[ai][bj][m][n]; ss += (v[0] * v[0] + v[1] * v[1]) + (v[2] * v[2] + v[3] * v[3]); }
                    ss += __shfl_xor(ss, 16); ss += __shfl_xor(ss, 32);
                    const float rstd = sc / sqrtf(ss * (1.0f / 64.0f) + NORM_EPS);
#pragma unroll
                    for (int bj = 0; bj < 2; ++bj) { const int pos = bj ? (t & 63) : (t >> 6);
                        const f32x4 cs = *(const f32x4*)(rope + pos * 16 + 4 * fq), sn = *(const f32x4*)(rope + 1024 + pos * 16 + 4 * fq);
                        const f32x4 x1 = acc[ai][bj][m][0] * rstd * gv[bj][0], x2 = acc[ai][bj][m][1] * rstd * gv[bj][1];
                        const f32x4 y1 = x1 * cs - x2 * sn, y2 = x2 * cs + x1 * sn;
                        v4u w; w.x = pg8::cvt_pk_bf16(y1[0], y1[1]); w.y = pg8::cvt_pk_bf16(y1[2], y1[3]); w.z = pg8::cvt_pk_bf16(y2[0], y2[1]); w.w = pg8::cvt_pk_bf16(y2[2], y2[3]);
                        *(v4u*)(base + (size_t)row * ldc + 32 * bj + 8 * fq) = w; } }
        }
    }
};
struct EpiF32 {
    static constexpr bool PERM = false, AFTER_DRAIN = false;
    float* O; int ldc;
    __device__ __forceinline__ void operator()(const f32x4 (&acc)[2][2][4][2], const pg8::Unit& u, int wr, int wc, int fr, int fq) const {
        const int row0 = u.pm * 256 + wr * 64 + fr, col0 = u.pn * 256 + wc * 32 + 4 * fq;
#pragma unroll
        for (int ai = 0; ai < 2; ++ai)
#pragma unroll
            for (int m = 0; m < 4; ++m) { float* rowp = O + (size_t)(row0 + ai * 128 + m * 16) * ldc + col0;
#pragma unroll
                for (int bj = 0; bj < 2; ++bj)
#pragma unroll
                    for (int n = 0; n < 2; ++n) *(f32x4*)(rowp + bj * 128 + n * 16) = acc[ai][bj][m][n]; }
    }
};

constexpr int TC = 32;
__device__ __forceinline__ void rwkv_scan_seq(Frame& F, int unit) {
    const Ptrs P = load_ptrs(F);
    const int z = unit >> 7, b = (unit >> 3) & 15, h = unit & 7, tid = F.tid, lane = F.lane;
    LAS float* L = (LAS float*)(F.lds + RING_OFF);
    LAS float* WUP = L;              LAS float* AUP = L + 4096;
    LAS float* RR = L + 8192;        LAS float* KR = RR + 2048;  LAS float* VV = KR + 2048;  LAS float* WD = VV + 2048;  LAS float* AD = WD + 2048;
    LAS float* WW = AD + 2048;       LAS float* KK = WW + 2048;  LAS float* AKK = KK + 2048; LAS float* KT = AKK + 2048;
    LAS float* YO = KT + 2048;       LAS float* BO = YO + 2048;
    for (int i = tid; i < 4096; i += 512) { const int r = i >> 6, c = i & 63; WUP[i] = P.w_up[(size_t)(z * 64 + r) * RW + h * 64 + c]; AUP[i] = P.a_up[(size_t)(z * 64 + r) * RW + h * 64 + c]; }
    float S[8];
#pragma unroll
    for (int j = 0; j < 8; ++j) S[j] = 0.f;
    const int c = tid & 63, sg = tid >> 6;
    const float w0c = P.w0[z * RW + h * 64 + c], a0c = P.a0[z * RW + h * 64 + c], kkc = P.k_k[h * 64 + c], kac = P.k_a[h * 64 + c], rkc = P.r_k[h * 64 + c];
    const int vrow = tid >> 3, ks = tid & 7;
    __syncthreads();
    for (int ch = 0; ch < T / TC; ++ch) {
        for (int i = tid; i < 5 * 2048; i += 512) {
            const int arr = i >> 11, rem = i & 2047, sl = rem >> 6, cc = rem & 63, s = ch * TC + sl, t = z ? (T - 1 - s) : s;
            const size_t row = (size_t)b * T + t;
            const bf16* src; int pitch, tapc;
            if (arr < 3) { src = P.RKV + arr * 512 + h * 64 + cc; pitch = 1536; tapc = arr * 512 + h * 64 + cc; }
            else { src = P.WA + (arr - 3) * 64 + cc; pitch = 128; tapc = 1536 + (arr - 3) * 64 + cc; }
            float val = P.taps[RSW + tapc] * bf2f(src[row * pitch]);
            if (t > 0) val += P.taps[tapc] * bf2f(src[(row - 1) * pitch]);
            if (t < T - 1) val += P.taps[2 * RSW + tapc] * bf2f(src[(row + 1) * pitch]);
            if (arr == 3) val = tanhf(val);
            RR[i] = val;
        }
        __syncthreads();
        {
            float wl[4], al[4];
#pragma unroll
            for (int j = 0; j < 4; ++j) { wl[j] = w0c; al[j] = a0c; }
            for (int r = 0; r < 64; r += 4) {
                float wu[4], au[4];
#pragma unroll
                for (int q = 0; q < 4; ++q) { wu[q] = WUP[(r + q) * 64 + c]; au[q] = AUP[(r + q) * 64 + c]; }
#pragma unroll
                for (int j = 0; j < 4; ++j) { const f32x4 wd = *(const LAS f32x4*)(WD + (4 * sg + j) * 64 + r), ad = *(const LAS f32x4*)(AD + (4 * sg + j) * 64 + r);
                    wl[j] += wd[0] * wu[0] + wd[1] * wu[1] + wd[2] * wu[2] + wd[3] * wu[3]; al[j] += ad[0] * au[0] + ad[1] * au[1] + ad[2] * au[2] + ad[3] * au[3]; }
            }
#pragma unroll
            for (int j = 0; j < 4; ++j) { const int sl = 4 * sg + j;
                const float w = __expf(-DECAY_SCALE * sigmoidf_(wl[j])), a = sigmoidf_(al[j]);
                const float kraw = KR[sl * 64 + c], kkv = kraw * kkc;
                const float ssq = wave_sum(kkv * kkv), kkn = kkv / sqrtf(ssq + L2_EPS);
                const float kt = kraw * (1.0f + (a - 1.0f) * kac);
                const float bon = wave_sum(RR[sl * 64 + c] * kt * rkc);
                WW[sl * 64 + c] = w; KK[sl * 64 + c] = kkn; AKK[sl * 64 + c] = a * kkn; KT[sl * 64 + c] = kt;
                if (lane == 0) BO[sl] = bon; }
        }
        __syncthreads();
        for (int sl = 0; sl < TC; ++sl) {
            const LAS float* pw = WW + sl * 64 + ks * 8; const LAS float* pk = KK + sl * 64 + ks * 8; const LAS float* pa = AKK + sl * 64 + ks * 8;
            const LAS float* pt = KT + sl * 64 + ks * 8; const LAS float* pr = RR + sl * 64 + ks * 8;
            const f32x4 w0v = *(const LAS f32x4*)pw, w1v = *(const LAS f32x4*)(pw + 4), k0v = *(const LAS f32x4*)pk, k1v = *(const LAS f32x4*)(pk + 4);
            const f32x4 a0v = *(const LAS f32x4*)pa, a1v = *(const LAS f32x4*)(pa + 4), t0v = *(const LAS f32x4*)pt, t1v = *(const LAS f32x4*)(pt + 4);
            const f32x4 r0v = *(const LAS f32x4*)pr, r1v = *(const LAS f32x4*)(pr + 4);
            const float vv = VV[sl * 64 + vrow];
            float sa = (S[0] * k0v[0] + S[1] * k0v[1]) + (S[2] * k0v[2] + S[3] * k0v[3]) + (S[4] * k1v[0] + S[5] * k1v[1]) + (S[6] * k1v[2] + S[7] * k1v[3]);
            sa += __shfl_xor(sa, 1); sa += __shfl_xor(sa, 2); sa += __shfl_xor(sa, 4);
#pragma unroll
            for (int j = 0; j < 4; ++j) { S[j] = S[j] * w0v[j] - sa * a0v[j] + vv * t0v[j]; S[4 + j] = S[4 + j] * w1v[j] - sa * a1v[j] + vv * t1v[j]; }
            float y = (S[0] * r0v[0] + S[1] * r0v[1]) + (S[2] * r0v[2] + S[3] * r0v[3]) + (S[4] * r1v[0] + S[5] * r1v[1]) + (S[6] * r1v[2] + S[7] * r1v[3]);
            y += __shfl_xor(y, 1); y += __shfl_xor(y, 2); y += __shfl_xor(y, 4);
            if (ks == 0) YO[sl * 64 + vrow] = y;
        }
        __syncthreads();
        for (int i = tid; i < 2048; i += 512) { const int sl = i >> 6, vc = i & 63, s = ch * TC + sl, t = z ? (T - 1 - s) : s;
            P.Y[((size_t)z * M + (size_t)b * T + t) * RW + h * 64 + vc] = YO[i]; }
        if (tid < TC) { const int s = ch * TC + tid, t = z ? (T - 1 - s) : s; P.BON[((size_t)z * M + (size_t)b * T + t) * 8 + h] = BO[tid]; }
    }
}
typedef unsigned u32x2 __attribute__((ext_vector_type(2)));
__device__ __forceinline__ unsigned cvtpk(float lo, float hi) { typedef float f2_ __attribute__((ext_vector_type(2))); typedef __bf16 b2_ __attribute__((ext_vector_type(2))); f2_ v = {lo, hi}; b2_ b = __builtin_convertvector(v, b2_); return __builtin_bit_cast(unsigned, b); }
template <int CTRL> __device__ __forceinline__ float dppf(float x) { return __builtin_bit_cast(float, __builtin_amdgcn_update_dpp(0, __builtin_bit_cast(int, x), CTRL, 0xf, 0xf, true)); }
__device__ __forceinline__ float reduce8(float x) { x += dppf<0xB1>(x); x += dppf<0x4E>(x); x += dppf<0x141>(x); return x; }
__device__ __forceinline__ float reduce16(float x) { x = reduce8(x); x += dppf<0x140>(x); return x; }
__device__ __forceinline__ bf16x8 frag_lo(f32x4 x) { v4u w = {cvtpk(x[0], x[1]), cvtpk(x[2], x[3]), 0u, 0u}; return __builtin_bit_cast(bf16x8, w); }
__device__ __forceinline__ bf16x8 frag_2(f32x4 x, f32x4 y) { v4u w = {cvtpk(x[0], x[1]), cvtpk(x[2], x[3]), cvtpk(y[0], y[1]), cvtpk(y[2], y[3])}; return __builtin_bit_cast(bf16x8, w); }
__device__ __forceinline__ bf16x8 frag_lo_u(u32x2 x) { v4u w = {x[0], x[1], 0u, 0u}; return __builtin_bit_cast(bf16x8, w); }
__device__ __forceinline__ f32x4 mfma16(bf16x8 a, bf16x8 b, f32x4 c) { return __builtin_amdgcn_mfma_f32_16x16x32_bf16(a, b, c, 0, 0, 0); }
__device__ __forceinline__ float fsig(float v) { return __builtin_amdgcn_rcpf(1.0f + __builtin_amdgcn_exp2f(-1.4426950408889634f * v)); }
__device__ __forceinline__ int kpos(int k) { return 32 * (k >> 5) + 8 * ((k >> 2) & 3) + 4 * ((k >> 4) & 1) + (k & 3); }
constexpr int O_WUPT = 0, O_AUPT = 8192, O_TAPS = 16384, O_CONST = 20480, O_RNS = 22528, O_BONS = 22784, O_GC = 23040, O_SHR = 24576, O_SHK = 40960, O_TW = 57344, O_AD = 65536, O_VT = 73728,
              O_AT = 81920, O_RT = 90112, O_BT = 98304, O_KT = 106496, O_BK = 114688, O_TA = 131072, O_AAK = 133120, O_ARBK = 135168, O_SCAN_END = 139264, O_YST = O_SHR;
constexpr float LOG2E = 1.4426950408889634f;
__device__ __forceinline__ void rwkv_scan_chunked(Frame& F, int unit) {
    const Ptrs P = load_ptrs(F);
    const int z = unit >> 7, b = (unit >> 3) & 15, h = unit & 7, tid0 = F.tid, w = F.wave;
#define OPAQUE_IDS int tid = tid0; asm volatile("" : "+v"(tid)); const int lane = tid & 63, fr = lane & 15, fq = lane >> 4; (void)lane; (void)fr; (void)fq;
    LAS unsigned char* L = F.lds;
    LAS float* TAPS = (LAS float*)(L + O_TAPS); LAS float* CST = (LAS float*)(L + O_CONST); LAS float* RNS = (LAS float*)(L + O_RNS); LAS float* BONS = (LAS float*)(L + O_BONS); LAS float* GC = (LAS float*)(L + O_GC);
    LAS float* SHR = (LAS float*)(L + O_SHR); LAS float* SHK = (LAS float*)(L + O_SHK); LAS float* YST = (LAS float*)(L + O_YST);
    { OPAQUE_IDS
    for (int i = tid; i < 4096; i += 512) { const int ch = i >> 6, rk = i & 63;
        ((LAS bf16*)(L + O_WUPT))[i] = (bf16)f2bf(P.w_up[(size_t)(z * 64 + rk) * RW + h * 64 + ch]); ((LAS bf16*)(L + O_AUPT))[i] = (bf16)f2bf(P.a_up[(size_t)(z * 64 + rk) * RW + h * 64 + ch]); }
    for (int i = tid; i < 960; i += 512) { const int j = i / 320, idx = i % 320; const int col = idx < 192 ? (idx >> 6) * 512 + h * 64 + (idx & 63) : 1536 + (idx - 192); TAPS[i] = P.taps[j * RSW + col]; }
    if (tid < 64) { CST[tid] = P.k_k[h * 64 + tid]; CST[64 + tid] = P.k_a[h * 64 + tid]; CST[128 + tid] = P.r_k[h * 64 + tid]; CST[192 + tid] = P.w0[z * RW + h * 64 + tid]; CST[256 + tid] = P.a0[z * RW + h * 64 + tid]; RNS[tid] = 0.f; }
    }
    f32x4 St[4];
#pragma unroll
    for (int i = 0; i < 4; ++i) St[i] = (f32x4){0.f, 0.f, 0.f, 0.f};
    __syncthreads();
    for (int n = 0; n < T / 64; ++n) {
        const int tlo = z ? (T - 64 * (n + 1)) : 64 * n;
        { OPAQUE_IDS
        if (w < 5) {
            const int cc = lane & 7, rg = lane >> 3, cchunk = w * 8 + cc, arr = w < 3 ? w : 3;
            const bf16* src; size_t pitch;
            if (arr < 3) { src = P.RKV + arr * 512 + h * 64 + cc * 8; pitch = 1536; } else { src = P.WA + (cchunk - 24) * 8; pitch = 128; }
            v4u x[10];
#pragma unroll
            for (int i = 0; i < 10; ++i) { const int t = tlo - 1 + 8 * rg + i; x[i] = (t >= 0 && t < T) ? *(const GAS v4u*)(src + ((size_t)b * T + t) * pitch) : (v4u){0u, 0u, 0u, 0u}; }
            float tp[3][8];
#pragma unroll
            for (int j = 0; j < 3; ++j) { const f32x4 a = *(const LAS f32x4*)(TAPS + j * 320 + cchunk * 8), c = *(const LAS f32x4*)(TAPS + j * 320 + cchunk * 8 + 4);
                tp[j][0] = a[0]; tp[j][1] = a[1]; tp[j][2] = a[2]; tp[j][3] = a[3]; tp[j][4] = c[0]; tp[j][5] = c[1]; tp[j][6] = c[2]; tp[j][7] = c[3]; }
            float kc[8];
            if (arr == 1) {
#pragma unroll
                for (int e = 0; e < 8; ++e) kc[e] = CST[cc * 8 + e]; }
            unsigned vpk[8][4];
#pragma unroll
            for (int o = 0; o < 8; ++o) {
                const int sl = z ? (63 - 8 * rg - o) : (8 * rg + o);
                float val[8];
#pragma unroll
                for (int e = 0; e < 8; ++e) { const int d = e >> 1;
                    const float x0 = (e & 1) ? __uint_as_float(x[o][d] & 0xffff0000u) : __uint_as_float(x[o][d] << 16);
                    const float x1 = (e & 1) ? __uint_as_float(x[o + 1][d] & 0xffff0000u) : __uint_as_float(x[o + 1][d] << 16);
                    const float x2 = (e & 1) ? __uint_as_float(x[o + 2][d] & 0xffff0000u) : __uint_as_float(x[o + 2][d] << 16);
                    val[e] = tp[0][e] * x0 + tp[1][e] * x1 + tp[2][e] * x2; }
                if (arr == 0) { *(LAS f32x4*)(SHR + sl * 64 + cc * 8) = (f32x4){val[0], val[1], val[2], val[3]}; *(LAS f32x4*)(SHR + sl * 64 + cc * 8 + 4) = (f32x4){val[4], val[5], val[6], val[7]}; }
                else if (arr == 1) { *(LAS f32x4*)(SHK + sl * 64 + cc * 8) = (f32x4){val[0], val[1], val[2], val[3]}; *(LAS f32x4*)(SHK + sl * 64 + cc * 8 + 4) = (f32x4){val[4], val[5], val[6], val[7]};
                    float ss = 0.f;
#pragma unroll
                    for (int e = 0; e < 8; ++e) { const float q = val[e] * kc[e]; ss += q * q; }
                    __hip_atomic_fetch_add(RNS + sl, ss, __ATOMIC_RELAXED, __HIP_MEMORY_SCOPE_WORKGROUP); }
                else if (arr == 2) {
#pragma unroll
                    for (int e = 0; e < 8; ++e) { const unsigned hb = cvtpk(val[e], 0.f); if (o & 1) vpk[e][o >> 1] |= hb << 16; else vpk[e][o >> 1] = hb; }
                }
                else { const bool iswd = cchunk < 32;
                    if (iswd) {
#pragma unroll
                        for (int e = 0; e < 8; ++e) { const float ex = __builtin_amdgcn_exp2f(2.0f * LOG2E * val[e]); val[e] = 1.0f - 2.0f * __builtin_amdgcn_rcpf(ex + 1.0f); } }
                    v4u wv = {cvtpk(val[0], val[1]), cvtpk(val[2], val[3]), cvtpk(val[4], val[5]), cvtpk(val[6], val[7])};
                    *(LAS v4u*)(L + (iswd ? O_TW : O_AD) + sl * 128 + (cchunk & 7) * 16) = wv; }
            }
            if (arr == 2) { const int sl0 = z ? (56 - 8 * rg) : 8 * rg;
#pragma unroll
                for (int e = 0; e < 8; ++e) { v4u o4;
                    if (z) o4 = (v4u){(vpk[e][3] >> 16) | (vpk[e][3] << 16), (vpk[e][2] >> 16) | (vpk[e][2] << 16), (vpk[e][1] >> 16) | (vpk[e][1] << 16), (vpk[e][0] >> 16) | (vpk[e][0] << 16)};
                    else o4 = (v4u){vpk[e][0], vpk[e][1], vpk[e][2], vpk[e][3]};
                    *(LAS v4u*)(L + O_VT + (cc * 8 + e) * 128 + sl0 * 2) = o4; } }
        } else if (w == 5) BONS[lane] = 0.f;
        }
        __syncthreads();
        { OPAQUE_IDS
            const int mt = w >> 1;
            const bf16x8 tw0 = *(const LAS bf16x8*)(L + O_TW + (16 * mt + fr) * 128 + fq * 16), tw1 = *(const LAS bf16x8*)(L + O_TW + (16 * mt + fr) * 128 + 64 + fq * 16);
            const bf16x8 ad0 = *(const LAS bf16x8*)(L + O_AD + (16 * mt + fr) * 128 + fq * 16), ad1 = *(const LAS bf16x8*)(L + O_AD + (16 * mt + fr) * 128 + 64 + fq * 16);
#pragma unroll
            for (int gi = 0; gi < 2; ++gi) {
                const int ng = 2 * (w & 1) + gi, ch = 16 * ng + fr, cp = kpos(ch);
                const bf16x8 wu0 = *(const LAS bf16x8*)(L + O_WUPT + ch * 128 + fq * 16), wu1 = *(const LAS bf16x8*)(L + O_WUPT + ch * 128 + 64 + fq * 16);
                const bf16x8 au0 = *(const LAS bf16x8*)(L + O_AUPT + ch * 128 + fq * 16), au1 = *(const LAS bf16x8*)(L + O_AUPT + ch * 128 + 64 + fq * 16);
                f32x4 accw = mfma16(tw0, wu0, (f32x4){0.f, 0.f, 0.f, 0.f}); accw = mfma16(tw1, wu1, accw);
                f32x4 acca = mfma16(ad0, au0, (f32x4){0.f, 0.f, 0.f, 0.f}); acca = mfma16(ad1, au1, acca);
                const float kkc = CST[ch], kac = CST[64 + ch], rkc = CST[128 + ch], w0c = CST[192 + ch], a0c = CST[256 + ch];
                float lw[4], g[4];
#pragma unroll
                for (int r = 0; r < 4; ++r) lw[r] = -(DECAY_SCALE * LOG2E) * fsig(accw[r] + w0c);
                g[0] = lw[0]; g[1] = g[0] + lw[1]; g[2] = g[1] + lw[2]; g[3] = g[2] + lw[3];
                const float t0 = __shfl(g[3], fr), t1 = __shfl(g[3], fr + 16), t2 = __shfl(g[3], fr + 32), t3 = __shfl(g[3], fr + 48);
                const float ex = (fq > 0 ? t0 : 0.f) + (fq > 1 ? t1 : 0.f) + (fq > 2 ? t2 : 0.f), gC = (t0 + t1) + (t2 + t3);
                float bh[4], kh[4];
#pragma unroll
                for (int r = 0; r < 4; ++r) {
                    const int sl = 16 * mt + 4 * fq + r;
                    const float gi_ = ex + g[r], gm1 = gi_ - lw[r];
                    const float rsh = SHR[sl * 64 + ch], ksh = SHK[sl * 64 + ch], rn = __builtin_amdgcn_rsqf(RNS[sl] + L2_EPS);
                    const float a = fsig(acca[r] + a0c);
                    const float kk = ksh * kkc * rn, kt = ksh * (1.0f + (a - 1.0f) * kac), akk = a * kk;
                    const float e1 = __builtin_amdgcn_exp2f(gm1), e2 = __builtin_amdgcn_exp2f(-gi_), e3 = __builtin_amdgcn_exp2f(gi_), e4 = __builtin_amdgcn_exp2f(gC - gi_);
                    ((LAS bf16*)(L + O_AT))[sl * 64 + cp] = (bf16)cvtpk(-kk * e1, 0.f);
                    ((LAS bf16*)(L + O_BT))[sl * 64 + cp] = (bf16)cvtpk(akk * e2, 0.f);
                    ((LAS bf16*)(L + O_KT))[sl * 64 + cp] = (bf16)cvtpk(kt * e2, 0.f);
                    ((LAS bf16*)(L + O_RT))[sl * 64 + cp] = (bf16)cvtpk(rsh * e3, 0.f);
                    bh[r] = akk * e4; kh[r] = kt * e4;
                    float bon = rsh * kt * rkc;
                    bon = reduce16(bon);
                    if (fr == 0) __hip_atomic_fetch_add(BONS + sl, bon, __ATOMIC_RELAXED, __HIP_MEMORY_SCOPE_WORKGROUP);
                }
                *(LAS v4u*)(L + O_BK + ((mt * 64 + ch) * 32 + fq * 8) * 2) = (v4u){cvtpk(bh[0], bh[1]), cvtpk(bh[2], bh[3]), cvtpk(kh[0], kh[1]), cvtpk(kh[2], kh[3])};
                if (fq == 0) GC[mt * 64 + ch] = __builtin_amdgcn_exp2f(gC);
            }
        }
        __syncthreads();
        { OPAQUE_IDS
            const int ck = w & 3; const f32x4 Z4 = (f32x4){0.f, 0.f, 0.f, 0.f};
            const int ro = (16 * ck + fr) * 128 + fq * 16;
            const bf16x8 af0 = *(const LAS bf16x8*)(L + O_AT + ro), af1 = *(const LAS bf16x8*)(L + O_AT + ro + 64);
            if (w < 4) {
                const bf16x8 bf0 = *(const LAS bf16x8*)(L + O_BT + ro), bf1 = *(const LAS bf16x8*)(L + O_BT + ro + 64);
                f32x4 X = mfma16(af0, bf0, Z4); X = mfma16(af1, bf1, X);
                f32x4 XT = mfma16(bf0, af0, Z4); XT = mfma16(bf1, af1, XT);
#pragma unroll
                for (int r = 0; r < 4; ++r) { if (!(fr < 4 * fq + r)) X[r] = 0.f; if (!(4 * fq + r < fr)) XT[r] = 0.f; }
                bf16x8 cx = frag_lo(X), cxt = frag_lo(XT);
                f32x4 X2 = mfma16(cxt, cx, Z4), X2T = mfma16(cx, cxt, Z4);
                bf16x8 c2 = frag_lo(X2), c2t = frag_lo(X2T);
                f32x4 X4 = mfma16(c2t, c2, Z4), X4T = mfma16(c2, c2t, Z4);
                bf16x8 c4 = frag_lo(X4), c4t = frag_lo(X4T);
                f32x4 X8 = mfma16(c4t, c4, Z4);
                f32x4 Q = XT;
#pragma unroll
                for (int r = 0; r < 4; ++r) if (4 * fq + r == fr) Q[r] += 1.0f;
                Q = mfma16(c2, frag_lo(Q), Q);
                Q = mfma16(c4, frag_lo(Q), Q);
                Q = mfma16(frag_lo(X8), frag_lo(Q), Q);
                *(LAS u32x2*)(L + O_TA + ((16 * ck + fr) * 16 + 4 * fq) * 2) = (u32x2){cvtpk(Q[0], Q[1]), cvtpk(Q[2], Q[3])};
            } else {
                const bf16x8 bf0 = *(const LAS bf16x8*)(L + O_BT + ro), bf1 = *(const LAS bf16x8*)(L + O_BT + ro + 64);
                const bf16x8 kf0 = *(const LAS bf16x8*)(L + O_KT + ro), kf1 = *(const LAS bf16x8*)(L + O_KT + ro + 64);
                const bf16x8 rf0 = *(const LAS bf16x8*)(L + O_RT + ro), rf1 = *(const LAS bf16x8*)(L + O_RT + ro + 64);
                f32x4 AkT = mfma16(kf0, af0, Z4); AkT = mfma16(kf1, af1, AkT);
                f32x4 RbT = mfma16(bf0, rf0, Z4); RbT = mfma16(bf1, rf1, RbT);
                f32x4 RkT = mfma16(kf0, rf0, Z4); RkT = mfma16(kf1, rf1, RkT);
#pragma unroll
                for (int r = 0; r < 4; ++r) { if (!(4 * fq + r < fr)) AkT[r] = 0.f; if (!(4 * fq + r <= fr)) { RbT[r] = 0.f; RkT[r] = 0.f; } }
                *(LAS u32x2*)(L + O_AAK + ((16 * ck + fr) * 16 + 4 * fq) * 2) = (u32x2){cvtpk(AkT[0], AkT[1]), cvtpk(AkT[2], AkT[3])};
                *(LAS v4u*)(L + O_ARBK + ((16 * ck + fr) * 32 + 8 * fq) * 2) = (v4u){cvtpk(RbT[0], RbT[1]), cvtpk(RbT[2], RbT[3]), cvtpk(RkT[0], RkT[1]), cvtpk(RkT[2], RkT[3])};
            }
        }
        __syncthreads();
        { OPAQUE_IDS
        if (w < 4) {
#pragma unroll 1
            for (int ck = 0; ck < 4; ++ck) {
                const int ro = (16 * ck + fr) * 128 + fq * 16; const f32x4 Z4 = (f32x4){0.f, 0.f, 0.f, 0.f};
                const bf16x8 af0 = *(const LAS bf16x8*)(L + O_AT + ro), af1 = *(const LAS bf16x8*)(L + O_AT + ro + 64);
                const bf16x8 rf0 = *(const LAS bf16x8*)(L + O_RT + ro), rf1 = *(const LAS bf16x8*)(L + O_RT + ro + 64);
                const bf16x8 aakf = frag_lo_u(*(const LAS u32x2*)(L + O_AAK + ((16 * ck + fr) * 16 + 4 * fq) * 2));
                const bf16x8 taf = frag_lo_u(*(const LAS u32x2*)(L + O_TA + ((16 * ck + fr) * 16 + 4 * fq) * 2));
                const bf16x8 arbkf = *(const LAS bf16x8*)(L + O_ARBK + ((16 * ck + fr) * 32 + 8 * fq) * 2);
                const u32x2 vv = *(const LAS u32x2*)(L + O_VT + (16 * w + fr) * 128 + (16 * ck + 4 * fq) * 2);
                const bf16x8 sb01 = frag_2(St[0], St[1]), sb23 = frag_2(St[2], St[3]);
                f32x4 U0 = mfma16(aakf, frag_lo_u(vv), Z4); U0 = mfma16(af0, sb01, U0); U0 = mfma16(af1, sb23, U0);
                const f32x4 U = mfma16(taf, frag_lo(U0), Z4);
                v4u uvw = {cvtpk(U[0], U[1]), cvtpk(U[2], U[3]), vv[0], vv[1]}; const bf16x8 uvb = __builtin_bit_cast(bf16x8, uvw);
                f32x4 Y = mfma16(rf0, sb01, Z4); Y = mfma16(rf1, sb23, Y); Y = mfma16(arbkf, uvb, Y);
#pragma unroll
                for (int kt = 0; kt < 4; ++kt) {
                    const f32x4 gc = *(const LAS f32x4*)(GC + ck * 64 + 16 * kt + 4 * fq);
                    const bf16x8 bkf = *(const LAS bf16x8*)(L + O_BK + ((ck * 64 + 16 * kt + fr) * 32 + 8 * fq) * 2);
                    St[kt] = mfma16(bkf, uvb, St[kt] * gc);
                }
#pragma unroll
                for (int r = 0; r < 4; ++r) YST[(16 * ck + 4 * fq + r) * 64 + 16 * w + fr] = Y[r];
            }
        } else if (w == 4) RNS[lane] = 0.f;
        }
        __syncthreads();
        { OPAQUE_IDS
        { const int sl = tid >> 3, v8 = (tid & 7) * 8, t = z ? (tlo + 63 - sl) : (tlo + sl);
          const f32x4 ya = *(const LAS f32x4*)(YST + sl * 64 + v8), yb = *(const LAS f32x4*)(YST + sl * 64 + v8 + 4);
          *(GAS v4u*)((bf16*)P.Y + ((size_t)z * M + (size_t)b * T + t) * RW + h * 64 + v8) = (v4u){cvtpk(ya[0], ya[1]), cvtpk(ya[2], ya[3]), cvtpk(yb[0], yb[1]), cvtpk(yb[2], yb[3])}; }
        if (tid < 64) { const int t = z ? (tlo + 63 - tid) : (tlo + tid); P.BON[((size_t)z * M + (size_t)b * T + t) * 8 + h] = BONS[tid]; }
        }
        __syncthreads();
    }
#undef OPAQUE_IDS
}
static_assert(O_SCAN_END <= RING_BYTES, "scan LDS");
__device__ __forceinline__ void p3_pre(Frame& F) {
    const Ptrs P = load_ptrs(F);
    const int gw = F.vcu * NWAVES + F.wave, NGW = F.G * NWAVES, lane = F.lane;
    float tp[3][2];
#pragma unroll
    for (int j = 0; j < 3; ++j) { tp[j][0] = P.taps[j * RSW + 1536 + 2 * lane]; tp[j][1] = P.taps[j * RSW + 1536 + 2 * lane + 1]; }
    for (int grp = gw; grp < M / 16; grp += NGW) {
        const int m0 = grp * 16, t0 = m0 & (T - 1);
        unsigned x[18];
#pragma unroll
        for (int i = 0; i < 18; ++i) { const int t = t0 - 1 + i; x[i] = (t >= 0 && t < T) ? *(const GAS unsigned*)(P.WA + (size_t)(m0 - 1 + i) * 128 + 2 * lane) : 0u; }
#pragma unroll
        for (int o = 0; o < 16; ++o) {
            float v0 = tp[0][0] * __uint_as_float(x[o] << 16) + tp[1][0] * __uint_as_float(x[o + 1] << 16) + tp[2][0] * __uint_as_float(x[o + 2] << 16);
            float v1 = tp[0][1] * __uint_as_float(x[o] & 0xffff0000u) + tp[1][1] * __uint_as_float(x[o + 1] & 0xffff0000u) + tp[2][1] * __uint_as_float(x[o + 2] & 0xffff0000u);
            if (lane < 32) { const float e0 = __builtin_amdgcn_exp2f(2.0f * LOG2E * v0), e1 = __builtin_amdgcn_exp2f(2.0f * LOG2E * v1);
                v0 = 1.0f - 2.0f * __builtin_amdgcn_rcpf(e0 + 1.0f); v1 = 1.0f - 2.0f * __builtin_amdgcn_rcpf(e1 + 1.0f); }
            bf16* dst = (lane < 32) ? (P.TWG + (size_t)(m0 + o) * 64 + 2 * lane) : (P.ADG + (size_t)(m0 + o) * 64 + 2 * (lane - 32));
            *(GAS unsigned*)dst = cvtpk(v0, v1);
        }
    }
}
__device__ __forceinline__ void ctr_arrive(Frame& F, int word) {
    asm volatile("s_waitcnt vmcnt(0)" ::: "memory"); __syncthreads();
    if (F.tid == 0) { __builtin_amdgcn_fence(__ATOMIC_RELEASE, "agent"); asm volatile("s_waitcnt vmcnt(0)" ::: "memory"); __hip_atomic_fetch_add((unsigned*)(F.ctl + word), 1u, __ATOMIC_RELAXED, __HIP_MEMORY_SCOPE_AGENT); }
}
__device__ __forceinline__ void ctr_wait(Frame& F, int word, unsigned want) {
    if (F.tid == 0) { unsigned sp = 0;
        while (__hip_atomic_load((unsigned*)(F.ctl + word), __ATOMIC_RELAXED, __HIP_MEMORY_SCOPE_AGENT) < want) { __builtin_amdgcn_s_sleep(2); if (++sp > (1u << 22)) break; }
        __builtin_amdgcn_fence(__ATOMIC_ACQUIRE, "agent"); asm volatile("s_waitcnt vmcnt(0)" ::: "memory"); }
    __syncthreads();
}

constexpr int Q_WUPT = 0, Q_AUPT = 8192, Q_TAPS = 16384, Q_CONST = 18944, Q_RNS = 20224, Q_BONS = 20480, Q_GC = 20992, Q_SHR = 22528, Q_SHK = 38912, Q_VT = 55296,
              Q_AT = 71680, Q_RT = 79872, Q_BT = 88064, Q_KT = 96256, Q_BK = 104448, Q_TA = 120832, Q_AAK = 122880, Q_ARBK = 124928, Q_YSB = 129024, Q_END = 137216;
static_assert(Q_END <= RING_BYTES, "scan LDS");
__device__ __forceinline__ void rwkv_scan_v4(Frame& F, int unit) {
    const Ptrs P = load_ptrs(F);
    const int z = unit >> 7, b = (unit >> 3) & 15, h = unit & 7, tid0 = F.tid, w = F.wave;
#define OPAQUE_IDS int tid = tid0; asm volatile("" : "+v"(tid)); const int lane = tid & 63, fr = lane & 15, fq = lane >> 4; (void)lane; (void)fr; (void)fq;
    LAS unsigned char* L = F.lds;
    LAS float* TAPS = (LAS float*)(L + Q_TAPS); LAS float* CST = (LAS float*)(L + Q_CONST); LAS float* RNS = (LAS float*)(L + Q_RNS); LAS float* BONS = (LAS float*)(L + Q_BONS); LAS float* GC = (LAS float*)(L + Q_GC);
    LAS float* SHR = (LAS float*)(L + Q_SHR); LAS float* SHK = (LAS float*)(L + Q_SHK);
    const size_t rowb = (size_t)b * T;
    { OPAQUE_IDS
    for (int i = tid; i < 4096; i += 512) { const int ch = i >> 6, rk = i & 63;
        ((LAS bf16*)(L + Q_WUPT))[i] = (bf16)f2bf(P.w_up[(size_t)(z * 64 + rk) * RW + h * 64 + ch]); ((LAS bf16*)(L + Q_AUPT))[i] = (bf16)f2bf(P.a_up[(size_t)(z * 64 + rk) * RW + h * 64 + ch]); }
    for (int i = tid; i < 576; i += 512) { const int j = i / 192, idx = i % 192; TAPS[i] = P.taps[j * RSW + (idx >> 6) * 512 + h * 64 + (idx & 63)]; }
    if (tid < 64) { CST[tid] = P.k_k[h * 64 + tid]; CST[64 + tid] = P.k_a[h * 64 + tid]; CST[128 + tid] = P.r_k[h * 64 + tid]; CST[192 + tid] = P.w0[z * RW + h * 64 + tid]; CST[256 + tid] = P.a0[z * RW + h * 64 + tid]; RNS[tid] = 0.f; BONS[tid] = 0.f; BONS[64 + tid] = 0.f; }
    }
    f32x4 St[4];
#pragma unroll
    for (int i = 0; i < 4; ++i) St[i] = (f32x4){0.f, 0.f, 0.f, 0.f};
    v4u xr[10];
    bf16x8 twf0, twf1, adf0, adf1;
#pragma unroll
    for (int i = 0; i < 10; ++i) xr[i] = (v4u){0u, 0u, 0u, 0u};
    twf0 = twf1 = adf0 = adf1 = (bf16x8){0, 0, 0, 0, 0, 0, 0, 0};
#define TLO(nn) (z ? (T - 64 * ((nn) + 1)) : 64 * (nn))
    const __amdgpu_buffer_rsrc_t rkv_rsrc = __builtin_amdgcn_make_buffer_rsrc((void*)(P.RKV + rowb * 1536), (short)0, T * 1536 * 2, 0x00020000);
#define A0_LOAD(nn) do { OPAQUE_IDS const int cc = lane & 7, rg = lane >> 3; const bool act_ = (w >= 4) && (w < 7) && ((nn) < T / 64); const int tl_ = TLO(nn), cb_ = ((w & 3) * 512 + h * 64 + cc * 8) * 2; \
        _Pragma("unroll") for (int i = 0; i < 10; ++i) { const int t = tl_ - 1 + 8 * rg + i; const unsigned off_ = (act_ && t >= 0 && t < T) ? (unsigned)(t * 3072 + cb_) : 0x7fffffffu; \
            xr[i] = __builtin_bit_cast(v4u, __builtin_amdgcn_raw_buffer_load_b128(rkv_rsrc, off_, 0, 0)); } } while (0)
#define TW_LOAD(nn) do { OPAQUE_IDS const int sl = 16 * (w >> 1) + fr, tl_ = TLO(nn), t = z ? (tl_ + 63 - sl) : (tl_ + sl); const bf16* pt = P.TWG + (rowb + t) * 64 + fq * 8; const bf16* pa = P.ADG + (rowb + t) * 64 + fq * 8; \
        twf0 = *(const GAS bf16x8*)pt; twf1 = *(const GAS bf16x8*)(pt + 32); adf0 = *(const GAS bf16x8*)pa; adf1 = *(const GAS bf16x8*)(pa + 32); } while (0)
#define A0_PROC(nn) do { if (w >= 4 && w < 7) { OPAQUE_IDS const int cc = lane & 7, rg = lane >> 3, arr = w - 4; \
        float tp[3][8]; \
        _Pragma("unroll") for (int j = 0; j < 3; ++j) { const f32x4 a_ = *(const LAS f32x4*)(TAPS + j * 192 + arr * 64 + cc * 8), c_ = *(const LAS f32x4*)(TAPS + j * 192 + arr * 64 + cc * 8 + 4); \
            tp[j][0] = a_[0]; tp[j][1] = a_[1]; tp[j][2] = a_[2]; tp[j][3] = a_[3]; tp[j][4] = c_[0]; tp[j][5] = c_[1]; tp[j][6] = c_[2]; tp[j][7] = c_[3]; } \
        float kc[8]; _Pragma("unroll") for (int e = 0; e < 8; ++e) kc[e] = CST[cc * 8 + e]; \
        unsigned vpk[8][4]; \
        _Pragma("unroll") for (int o = 0; o < 8; ++o) { const int sl = z ? (63 - 8 * rg - o) : (8 * rg + o); float val[8]; \
            _Pragma("unroll") for (int e = 0; e < 8; ++e) { const int d = e >> 1; \
                const float x0 = (e & 1) ? __uint_as_float(xr[o][d] & 0xffff0000u) : __uint_as_float(xr[o][d] << 16); \
                const float x1 = (e & 1) ? __uint_as_float(xr[o + 1][d] & 0xffff0000u) : __uint_as_float(xr[o + 1][d] << 16); \
                const float x2 = (e & 1) ? __uint_as_float(xr[o + 2][d] & 0xffff0000u) : __uint_as_float(xr[o + 2][d] << 16); \
                val[e] = tp[0][e] * x0 + tp[1][e] * x1 + tp[2][e] * x2; } \
            if (arr == 0) { *(LAS f32x4*)(SHR + sl * 64 + cc * 8) = (f32x4){val[0], val[1], val[2], val[3]}; *(LAS f32x4*)(SHR + sl * 64 + cc * 8 + 4) = (f32x4){val[4], val[5], val[6], val[7]}; } \
            else if (arr == 1) { *(LAS f32x4*)(SHK + sl * 64 + cc * 8) = (f32x4){val[0], val[1], val[2], val[3]}; *(LAS f32x4*)(SHK + sl * 64 + cc * 8 + 4) = (f32x4){val[4], val[5], val[6], val[7]}; \
                float ss = 0.f; _Pragma("unroll") for (int e = 0; e < 8; ++e) { const float q_ = val[e] * kc[e]; ss += q_ * q_; } \
                __hip_atomic_fetch_add(RNS + sl, ss, __ATOMIC_RELAXED, __HIP_MEMORY_SCOPE_WORKGROUP); } \
            else { _Pragma("unroll") for (int e = 0; e < 8; ++e) { if (o & 1) vpk[e][o >> 1] = cvtpk(val[e], 0.f) << 16 | (vpk[e][o >> 1] & 0xffffu); else vpk[e][o >> 1] = cvtpk(val[e], 0.f) & 0xffffu; } } } \
        if (arr == 2) { const int sl0 = z ? (56 - 8 * rg) : 8 * rg; \
            _Pragma("unroll") for (int e = 0; e < 8; ++e) { v4u o4; \
                if (z) o4 = (v4u){(vpk[e][3] >> 16) | (vpk[e][3] << 16), (vpk[e][2] >> 16) | (vpk[e][2] << 16), (vpk[e][1] >> 16) | (vpk[e][1] << 16), (vpk[e][0] >> 16) | (vpk[e][0] << 16)}; \
                else o4 = (v4u){vpk[e][0], vpk[e][1], vpk[e][2], vpk[e][3]}; \
                *(LAS v4u*)(L + Q_VT + ((nn) & 1) * 8192 + (cc * 8 + e) * 128 + sl0 * 2) = o4; } } } } while (0)
#define OUT_(nn) do { OPAQUE_IDS const int sl = tid >> 3, v8 = (tid & 7) * 8, tl_ = TLO(nn), t = z ? (tl_ + 63 - sl) : (tl_ + sl); \
        *(GAS v4u*)((bf16*)P.Y + ((size_t)z * M + rowb + t) * RW + h * 64 + v8) = *(const LAS v4u*)(L + Q_YSB + (sl * 64 + v8) * 2); \
        if (tid < 64) { const int t2 = z ? (tl_ + 63 - tid) : (tl_ + tid); P.BON[((size_t)z * M + rowb + t2) * 8 + h] = BONS[((nn) & 1) * 64 + tid]; } } while (0)
    __syncthreads();
    A0_LOAD(0); TW_LOAD(0);
    A0_PROC(0);
    A0_LOAD(1);
    __syncthreads();
#pragma unroll 1
    for (int n = 0; n < T / 64; ++n) {
        if (n > 0) OUT_(n - 1);
        { OPAQUE_IDS
            const int mt = w >> 1;
            LAS float* BONn = BONS + (n & 1) * 64;
#pragma unroll
            for (int gi = 0; gi < 2; ++gi) {
                const int ng = 2 * (w & 1) + gi, ch = 16 * ng + fr, cp = kpos(ch);
                const bf16x8 wu0 = *(const LAS bf16x8*)(L + Q_WUPT + ch * 128 + fq * 16), wu1 = *(const LAS bf16x8*)(L + Q_WUPT + ch * 128 + 64 + fq * 16);
                const bf16x8 au0 = *(const LAS bf16x8*)(L + Q_AUPT + ch * 128 + fq * 16), au1 = *(const LAS bf16x8*)(L + Q_AUPT + ch * 128 + 64 + fq * 16);
                f32x4 accw = mfma16(twf0, wu0, (f32x4){0.f, 0.f, 0.f, 0.f}); accw = mfma16(twf1, wu1, accw);
                f32x4 acca = mfma16(adf0, au0, (f32x4){0.f, 0.f, 0.f, 0.f}); acca = mfma16(adf1, au1, acca);
                const float kkc = CST[ch], kac = CST[64 + ch], rkc = CST[128 + ch], w0c = CST[192 + ch], a0c = CST[256 + ch];
                float lw[4], g[4];
#pragma unroll
                for (int r = 0; r < 4; ++r) lw[r] = -(DECAY_SCALE * LOG2E) * fsig(accw[r] + w0c);
                g[0] = lw[0]; g[1] = g[0] + lw[1]; g[2] = g[1] + lw[2]; g[3] = g[2] + lw[3];
                const float t0 = __shfl(g[3], fr), t1 = __shfl(g[3], fr + 16), t2 = __shfl(g[3], fr + 32), t3 = __shfl(g[3], fr + 48);
                const float ex = (fq > 0 ? t0 : 0.f) + (fq > 1 ? t1 : 0.f) + (fq > 2 ? t2 : 0.f), gC = (t0 + t1) + (t2 + t3);
                float bh[4], kh[4];
#pragma unroll
                for (int r = 0; r < 4; ++r) {
                    const int sl = 16 * mt + 4 * fq + r;
                    const float gi_ = ex + g[r], gm1 = gi_ - lw[r];
                    const float rsh = SHR[sl * 64 + ch], ksh = SHK[sl * 64 + ch], rn = __builtin_amdgcn_rsqf(RNS[sl] + L2_EPS);
                    const float a = fsig(acca[r] + a0c);
                    const float kk = ksh * kkc * rn, kt = ksh * (1.0f + (a - 1.0f) * kac), akk = a * kk;
                    const float e1 = __builtin_amdgcn_exp2f(gm1), e2 = __builtin_amdgcn_exp2f(-gi_), e3 = __builtin_amdgcn_exp2f(gi_), e4 = __builtin_amdgcn_exp2f(gC - gi_);
                    ((LAS bf16*)(L + Q_AT))[sl * 64 + cp] = (bf16)cvtpk(-kk * e1, 0.f);
                    ((LAS bf16*)(L + Q_BT))[sl * 64 + cp] = (bf16)cvtpk(akk * e2, 0.f);
                    ((LAS bf16*)(L + Q_KT))[sl * 64 + cp] = (bf16)cvtpk(kt * e2, 0.f);
                    ((LAS bf16*)(L + Q_RT))[sl * 64 + cp] = (bf16)cvtpk(rsh * e3, 0.f);
                    bh[r] = akk * e4; kh[r] = kt * e4;
                    const float bon = reduce16(rsh * kt * rkc);
                    if (fr == 0) __hip_atomic_fetch_add(BONn + sl, bon, __ATOMIC_RELAXED, __HIP_MEMORY_SCOPE_WORKGROUP);
                }
                *(LAS v4u*)(L + Q_BK + ((mt * 64 + ch) * 32 + fq * 8) * 2) = (v4u){cvtpk(bh[0], bh[1]), cvtpk(bh[2], bh[3]), cvtpk(kh[0], kh[1]), cvtpk(kh[2], kh[3])};
                if (fq == 0) GC[mt * 64 + ch] = __builtin_amdgcn_exp2f(gC);
            }
        }
        __syncthreads();
        TW_LOAD((n + 1 < T / 64) ? n + 1 : n);
        { OPAQUE_IDS
            const int ck = w & 3; const f32x4 Z4 = (f32x4){0.f, 0.f, 0.f, 0.f};
            const int ro = (16 * ck + fr) * 128 + fq * 16;
            const bf16x8 af0 = *(const LAS bf16x8*)(L + Q_AT + ro), af1 = *(const LAS bf16x8*)(L + Q_AT + ro + 64);
            if (w < 4) {
                const bf16x8 bf0 = *(const LAS bf16x8*)(L + Q_BT + ro), bf1 = *(const LAS bf16x8*)(L + Q_BT + ro + 64);
                f32x4 X = mfma16(af0, bf0, Z4); X = mfma16(af1, bf1, X);
                f32x4 XT = mfma16(bf0, af0, Z4); XT = mfma16(bf1, af1, XT);
#pragma unroll
                for (int r = 0; r < 4; ++r) { if (!(fr < 4 * fq + r)) X[r] = 0.f; if (!(4 * fq + r < fr)) XT[r] = 0.f; }
                bf16x8 cx = frag_lo(X), cxt = frag_lo(XT);
                f32x4 X2 = mfma16(cxt, cx, Z4), X2T = mfma16(cx, cxt, Z4);
                bf16x8 c2 = frag_lo(X2), c2t = frag_lo(X2T);
                f32x4 X4 = mfma16(c2t, c2, Z4), X4T = mfma16(c2, c2t, Z4);
                bf16x8 c4 = frag_lo(X4), c4t = frag_lo(X4T);
                f32x4 X8 = mfma16(c4t, c4, Z4);
                f32x4 Q = XT;
#pragma unroll
                for (int r = 0; r < 4; ++r) if (4 * fq + r == fr) Q[r] += 1.0f;
                Q = mfma16(c2, frag_lo(Q), Q);
                Q = mfma16(c4, frag_lo(Q), Q);
                Q = mfma16(frag_lo(X8), frag_lo(Q), Q);
                *(LAS u32x2*)(L + Q_TA + ((16 * ck + fr) * 16 + 4 * fq) * 2) = (u32x2){cvtpk(Q[0], Q[1]), cvtpk(Q[2], Q[3])};
            } else {
                const bf16x8 bf0 = *(const LAS bf16x8*)(L + Q_BT + ro), bf1 = *(const LAS bf16x8*)(L + Q_BT + ro + 64);
                const bf16x8 kf0 = *(const LAS bf16x8*)(L + Q_KT + ro), kf1 = *(const LAS bf16x8*)(L + Q_KT + ro + 64);
                const bf16x8 rf0 = *(const LAS bf16x8*)(L + Q_RT + ro), rf1 = *(const LAS bf16x8*)(L + Q_RT + ro + 64);
                f32x4 AkT = mfma16(kf0, af0, Z4); AkT = mfma16(kf1, af1, AkT);
                f32x4 RbT = mfma16(bf0, rf0, Z4); RbT = mfma16(bf1, rf1, RbT);
                f32x4 RkT = mfma16(kf0, rf0, Z4); RkT = mfma16(kf1, rf1, RkT);
#pragma unroll
                for (int r = 0; r < 4; ++r) { if (!(4 * fq + r < fr)) AkT[r] = 0.f; if (!(4 * fq + r <= fr)) { RbT[r] = 0.f; RkT[r] = 0.f; } }
                *(LAS u32x2*)(L + Q_AAK + ((16 * ck + fr) * 16 + 4 * fq) * 2) = (u32x2){cvtpk(AkT[0], AkT[1]), cvtpk(AkT[2], AkT[3])};
                *(LAS v4u*)(L + Q_ARBK + ((16 * ck + fr) * 32 + 8 * fq) * 2) = (v4u){cvtpk(RbT[0], RbT[1]), cvtpk(RbT[2], RbT[3]), cvtpk(RkT[0], RkT[1]), cvtpk(RkT[2], RkT[3])};
            }
            if (w == 7) { RNS[lane] = 0.f; BONS[((n + 1) & 1) * 64 + lane] = 0.f; }
        }
        __syncthreads();
        if (w < 4) { OPAQUE_IDS
            const int vtb = Q_VT + (n & 1) * 8192;
#pragma unroll 1
            for (int ck = 0; ck < 4; ++ck) {
                const int ro = (16 * ck + fr) * 128 + fq * 16; const f32x4 Z4 = (f32x4){0.f, 0.f, 0.f, 0.f};
                const bf16x8 af0 = *(const LAS bf16x8*)(L + Q_AT + ro), af1 = *(const LAS bf16x8*)(L + Q_AT + ro + 64);
                const bf16x8 rf0 = *(const LAS bf16x8*)(L + Q_RT + ro), rf1 = *(const LAS bf16x8*)(L + Q_RT + ro + 64);
                const bf16x8 aakf = frag_lo_u(*(const LAS u32x2*)(L + Q_AAK + ((16 * ck + fr) * 16 + 4 * fq) * 2));
                const bf16x8 taf = frag_lo_u(*(const LAS u32x2*)(L + Q_TA + ((16 * ck + fr) * 16 + 4 * fq) * 2));
                const bf16x8 arbkf = *(const LAS bf16x8*)(L + Q_ARBK + ((16 * ck + fr) * 32 + 8 * fq) * 2);
                const u32x2 vv = *(const LAS u32x2*)(L + vtb + (16 * w + fr) * 128 + (16 * ck + 4 * fq) * 2);
                const bf16x8 sb01 = frag_2(St[0], St[1]), sb23 = frag_2(St[2], St[3]);
                f32x4 U0 = mfma16(aakf, frag_lo_u(vv), Z4); U0 = mfma16(af0, sb01, U0); U0 = mfma16(af1, sb23, U0);
                const f32x4 U = mfma16(taf, frag_lo(U0), Z4);
                v4u uvw = {cvtpk(U[0], U[1]), cvtpk(U[2], U[3]), vv[0], vv[1]}; const bf16x8 uvb = __builtin_bit_cast(bf16x8, uvw);
                f32x4 Y = mfma16(rf0, sb01, Z4); Y = mfma16(rf1, sb23, Y); Y = mfma16(arbkf, uvb, Y);
#pragma unroll
                for (int kt = 0; kt < 4; ++kt) {
                    const f32x4 gc = *(const LAS f32x4*)(GC + ck * 64 + 16 * kt + 4 * fq);
                    const bf16x8 bkf = *(const LAS bf16x8*)(L + Q_BK + ((ck * 64 + 16 * kt + fr) * 32 + 8 * fq) * 2);
                    St[kt] = mfma16(bkf, uvb, St[kt] * gc);
                }
#pragma unroll
                for (int r = 0; r < 4; ++r) ((LAS bf16*)(L + Q_YSB))[(16 * ck + 4 * fq + r) * 64 + 16 * w + fr] = (bf16)cvtpk(Y[r], 0.f);
            }
        } else {
            if (n + 1 < T / 64) A0_PROC(n + 1);
        }
        A0_LOAD(n + 2);
        __syncthreads();
    }
    OUT_(T / 64 - 1);
    __syncthreads();
#undef OPAQUE_IDS
#undef TLO
#undef A0_LOAD
#undef TW_LOAD
#undef A0_PROC
#undef OUT_
}
__device__ __forceinline__ void unpack8(const v4u p, float (&f)[8]) {
#pragma unroll
    for (int d = 0; d < 4; ++d) { f[2 * d] = __uint_as_float(p[d] << 16); f[2 * d + 1] = __uint_as_float(p[d] & 0xffff0000u); } }
__device__ __forceinline__ void mix_prep(Frame& F) {
    const Ptrs P = load_ptrs(F);
    const int gw = F.vcu * NWAVES + F.wave, NGW = F.G * NWAVES, lane = F.lane, hh = lane >> 3, col = hh * 64 + (lane & 7) * 8;
    float gw8[8], gb8[8], tp0[8], tp1[8], tp2[8];
#pragma unroll
    for (int e = 0; e < 8; ++e) { gw8[e] = P.gn_w[col + e]; gb8[e] = P.gn_b[col + e]; tp0[e] = P.taps[1024 + col + e]; tp1[e] = P.taps[RSW + 1024 + col + e]; tp2[e] = P.taps[2 * RSW + 1024 + col + e]; }
    const bf16* Yb = (const bf16*)P.Y;
    for (int m = gw; m < M; m += NGW) {
        const int t = m & (T - 1);
        const v4u y0p = *(const GAS v4u*)(Yb + (size_t)m * RW + col), y1p = *(const GAS v4u*)(Yb + ((size_t)M + m) * RW + col);
        const v4u gp = *(const GAS v4u*)(P.GRW + (size_t)m * 512 + col);
        const bf16* vsrc = P.RKV + 1024 + col;
        const v4u v1p = *(const GAS v4u*)(vsrc + (size_t)m * 1536);
        const v4u v0p = (t > 0) ? *(const GAS v4u*)(vsrc + (size_t)(m - 1) * 1536) : (v4u){0u, 0u, 0u, 0u};
        const v4u v2p = (t < T - 1) ? *(const GAS v4u*)(vsrc + (size_t)(m + 1) * 1536) : (v4u){0u, 0u, 0u, 0u};
        const float bon = P.BON[(size_t)m * 8 + hh] + P.BON[((size_t)M + m) * 8 + hh];
        float y0[8], y1[8], g[8], v0[8], v1[8], v2[8], y[8];
        unpack8(y0p, y0); unpack8(y1p, y1); unpack8(gp, g); unpack8(v0p, v0); unpack8(v1p, v1); unpack8(v2p, v2);
        float s = 0.f;
#pragma unroll
        for (int e = 0; e < 8; ++e) { y[e] = y0[e] + y1[e]; s += y[e]; }
        const float mu = reduce8(s) * (1.0f / 64.0f); float q = 0.f;
#pragma unroll
        for (int e = 0; e < 8; ++e) { y[e] -= mu; q += y[e] * y[e]; }
        const float rstd = __builtin_amdgcn_rsqf(reduce8(q) * (1.0f / 64.0f) + GN_EPS);
        float o[8];
#pragma unroll
        for (int e = 0; e < 8; ++e) { const float vs = tp0[e] * v0[e] + tp1[e] * v1[e] + tp2[e] * v2[e]; o[e] = (y[e] * rstd * gw8[e] + gb8[e] + bon * vs) * g[e]; }
        *(GAS v4u*)(P.MIX + (size_t)m * D + 512 + col) = (v4u){cvtpk(o[0], o[1]), cvtpk(o[2], o[3]), cvtpk(o[4], o[5]), cvtpk(o[6], o[7])};
    }
}
__device__ __forceinline__ void final_norm(Frame& F) {
    const Ptrs P = load_ptrs(F);
    const int gw = F.vcu * NWAVES + F.wave, NGW = F.G * NWAVES;
    for (int m = gw; m < M; m += NGW) {
        const int b = m / T;
        const GAS f32x4* orow = (const GAS f32x4*)(P.OUTPRE + (size_t)m * D) + F.lane; const GAS f32x4* xr = (const GAS f32x4*)(P.x + (size_t)m * D) + F.lane;
        f32x4 v[4]; float s = 0.f;
#pragma unroll
        for (int j = 0; j < 4; ++j) { v[j] = orow[64 * j]; s += (v[j].x * v[j].x + v[j].y * v[j].y) + (v[j].z * v[j].z + v[j].w * v[j].w); }
        const float rstd = 1.f / sqrtf(wave_sum(s) * (1.f / D) + NORM_EPS);
        GAS f32x4* o = (GAS f32x4*)(P.out + (size_t)m * D) + F.lane;
#pragma unroll
        for (int j = 0; j < 4; ++j) { const int d0 = 256 * j + 4 * F.lane; const f32x4 gp = *(const GAS f32x4*)(P.g_post + d0), gt = *(const GAS f32x4*)(P.MOD + b * 3 * D + 2 * D + d0);
            o[64 * j] = xr[64 * j] + gt * (v[j] * rstd * gp); }
    }
}

struct Args { const float* in[20]; float* out; unsigned char* ws; int ph_lo, ph_hi, li, pad; };
__global__ void __launch_bounds__(NWAVES * 64, 2) hyb_fwd(Args args) {
    extern __shared__ __attribute__((aligned(16))) unsigned char lds[];
    Frame F;
    F.lds = (LAS unsigned char*)lds;
    F.MISC = (volatile LAS unsigned*)(F.lds + MISC_OFF);
    F.tid = threadIdx.x; F.lane = F.tid & 63; F.wave = __builtin_amdgcn_readfirstlane(F.tid >> 6);
    F.G = gridDim.x; { const int bx = blockIdx.x; F.vcu = (F.G % 8 == 0) ? (bx % 8) * (F.G / 8) + bx / 8 : bx; }
#define GRID_BAR(seam) do { if (N_LAUNCHES == PER_PHASE) { if (F.tid == 0) __hip_atomic_store(F.ctl + CW_TMO, 0xBADBA0u | (unsigned)(seam), RLX_AGENT); } \
    else { xcd_barrier(bar); } } while (0)
    F.kp = (const CAS char*)__builtin_amdgcn_kernarg_segment_ptr();
    F.ctl = (gu32*)(args.ws + WS_CTL);
    for (int u = F.tid; u < (LDS_BYTES - LDSCTL_OFF) / 4; u += NWAVES * 64) ((LAS unsigned*)(F.lds + LDSCTL_OFF))[u] = 0u;
    __syncthreads();
    XcdBarrier bar; bar.bar = (unsigned*)(F.ctl + CW_BAR); bar.x = 0; bar.st = nullptr;
    if (N_LAUNCHES != PER_PHASE) bar = xcd_barrier_post((unsigned*)(F.ctl + CW_BAR), F.MISC + 8);

    const int lo = args.ph_lo, hi = args.ph_hi;
#define IN(k) (lo <= (k) && (k) < hi)
#ifndef PROBE_REPEAT
#define PROBE_REPEAT -1
#endif
#define REP(k) for (int rep_ = 0; rep_ < ((PROBE_REPEAT == (k)) ? 2 : 1); ++rep_)
#define BOTH(k) (IN(k) && IN((k) + 1))
    if (IN(0)) { p0_prologue(F); if (BOTH(0)) GRID_BAR(0); }
    if (IN(1)) { REP(1) p1_xn(F); if (BOTH(1)) GRID_BAR(1); }
    if (IN(2)) {
        const Ptrs P = load_ptrs(F);
        pg8::Gemm g{P.XN, P.Win_t, M, NINP, D}; pg8::StaticOrder S; S.init(M, NINP, F.G, (int)blockIdx.x);
        EpiInProj E{P.QB, P.KB, P.VB, P.GATT, P.RKV, P.WA, P.GRW, P.q_norm_g, P.k_norm_g, P.ROPE, attn_body::C2};
        REP(2) pg8::gemm_phase<EpiInProj, pg8::StaticOrder, PG8_ALIGN, PG8_SP2>(F.lds + RING_OFF, g, S, E);
        if (BOTH(2)) GRID_BAR(2);
    }
    if (IN(3)) {
        p3_pre(F); ctr_arrive(F, CW_PRE);
        { const Ptrs P = load_ptrs(F);
        const attn_body::AttnTensors AT{(const attn_body::bf16*)P.QB, (const attn_body::bf16*)P.KB, (const attn_body::bf16*)P.VB, (const attn_body::bf16*)P.GATT, (attn_body::bf16*)P.MIX};
        const attn_body::StaticOrder S((int)F.G, (int)blockIdx.x);
        REP(3) attn_body::attn_phase<attn_body::StaticOrder>((char*)lds + RING_OFF, AT, S); }
        __syncthreads();
#if defined(RWKV_SEQ)
        for (int u = F.vcu; u < 256; u += F.G) { rwkv_scan_seq(F, u); __syncthreads(); }
#else
        ctr_wait(F, CW_PRE, (unsigned)F.G);
        REP(7) for (int u = F.vcu; u < 256; u += F.G) { rwkv_scan_v4(F, u); __syncthreads(); }
#endif
        if (BOTH(3)) GRID_BAR(3);
    }
    if (IN(4)) { REP(4) mix_prep(F); if (BOTH(4)) GRID_BAR(4); }
    if (IN(5)) {
        const Ptrs P = load_ptrs(F);
        pg8::Gemm g{P.MIX, P.Wout_t, M, D, D}; pg8::StaticOrder S; S.init(M, D, F.G, (int)blockIdx.x);
        EpiF32 E{P.OUTPRE, D};
        REP(5) pg8::gemm_phase<EpiF32, pg8::StaticOrder, PG8_ALIGN, PG8_SP2>(F.lds + RING_OFF, g, S, E);
        if (BOTH(5)) GRID_BAR(5);
    }
    if (IN(6)) { REP(6) final_norm(F); }
#undef IN
#undef BOTH
}

extern "C" void kernel_launch(void* const* d_in, const int* in_sizes, int n_in, void* d_out, int out_size, void* d_ws, size_t ws_size, hipStream_t stream) {
    static int grid = 0;
    if (grid == 0) {
        if (n_in != 20 || in_sizes[0] != M * D || out_size != M * D || ws_size < WS_END) { fprintf(stderr, "kernel_launch: unexpected shapes (n_in %d, in0 %d, out %d, ws %zu); nothing launched\n", n_in, n_in > 0 ? in_sizes[0] : -1, out_size, ws_size); grid = -1; return; }
        int dev = 0, cus = 0, per_cu = 0;
        if (hipGetDevice(&dev) != hipSuccess || hipDeviceGetAttribute(&cus, hipDeviceAttributeMultiprocessorCount, dev) != hipSuccess) { grid = -1; return; }
        if (hipFuncSetAttribute((const void*)hyb_fwd, hipFuncAttributeMaxDynamicSharedMemorySize, LDS_BYTES) != hipSuccess) { fprintf(stderr, "kernel_launch: hipFuncSetAttribute failed\n"); grid = -1; return; }
        if (hipOccupancyMaxActiveBlocksPerMultiprocessor(&per_cu, (const void*)hyb_fwd, NWAVES * 64, LDS_BYTES) != hipSuccess || per_cu < 1)
            fprintf(stderr, "kernel_launch: note: occupancy query reports %d workgroups per CU\n", per_cu);
        (void)hipGetLastError();
        grid = cus;
    }
    if (grid < 0) return;
    if (hipMemsetAsync((char*)d_ws + WS_CTL, 0, CTL_ZERO_BYTES, stream) != hipSuccess) { fprintf(stderr, "kernel_launch: hipMemsetAsync failed\n"); return; }
    Args a{};
    for (int i = 0; i < 20; ++i) a.in[i] = (const float*)d_in[i];
    a.out = (float*)d_out; a.ws = (unsigned char*)d_ws;
    for (int li = 0; li < N_LAUNCHES; ++li) {
        a.ph_lo = (N_LAUNCHES == PER_PHASE) ? li : 0; a.ph_hi = (N_LAUNCHES == PER_PHASE) ? li + 1 : PER_PHASE; a.li = li;
        hipLaunchKernelGGL(hyb_fwd, dim3(grid), dim3(NWAVES * 64), LDS_BYTES, stream, a);
        const hipError_t le = hipPeekAtLastError();
        if (le != hipSuccess) { fprintf(stderr, "kernel_launch: launch %d failed: %s\n", li, hipGetErrorName(le)); break; }
    }
}
```
